# Optimizing an MI355X kernel written in HIP

```python
import jax, jax.numpy as jnp
from jax import lax
import numpy as np

D_MODEL = 1024
BATCH = 4
SEQ = 8192
DEPTH = 2

CHUNK = 64
Q_BLOCK = 128
PLE_DIM = 256
EPS = 1e-6
NEG_INF = -1e30

SGU_WIDTH = 512
SGU_GROUPS = 4
SGU_GROUP_DIM = SGU_WIDTH // SGU_GROUPS
SGU_BLOCK = 128
POOL_WINDOWS = (2, 4, 8, 16)
POOL_WIDTH = 512
POOL_GROUPS = len(POOL_WINDOWS)
POOL_GROUP_DIM = POOL_WIDTH // POOL_GROUPS
MLA_HEADS = 4
MLA_NOPE = 128
MLA_ROPE = 64
MLA_QK = MLA_NOPE + MLA_ROPE
MLA_V = 128
MLA_WIDTH = MLA_HEADS * MLA_V
MLA_Q_RANK = 256
MLA_KV_RANK = 128
ROPE_THETA = 10000.0
SB_HEADS = 4
SB_HEAD_DIM = 128
SB_WIDTH = SB_HEADS * SB_HEAD_DIM

N_BRANCH = 4
IN_SIZES = (SGU_WIDTH, SGU_WIDTH, SGU_WIDTH,
            POOL_WIDTH, POOL_WIDTH,
            MLA_Q_RANK, MLA_KV_RANK, MLA_ROPE, MLA_WIDTH,
            SB_WIDTH, SB_WIDTH, SB_WIDTH, SB_WIDTH,
            N_BRANCH * D_MODEL)
N_IN = sum(IN_SIZES)

kernel_name = 'hybrid_gated_parallel_streaming_block'


def rms_norm(x, g):
    xf = x.astype(jnp.float32)
    y = xf * lax.rsqrt(jnp.mean(xf * xf, axis=-1, keepdims=True) + EPS)
    return (y * g.astype(jnp.float32)).astype(x.dtype)


def layer_norm(x, g, b):
    xf = x.astype(jnp.float32)
    mu = jnp.mean(xf, axis=-1, keepdims=True)
    xc = xf - mu
    y = xc * lax.rsqrt(jnp.mean(xc * xc, axis=-1, keepdims=True) + EPS)
    return (y * g.astype(jnp.float32) + b.astype(jnp.float32)).astype(x.dtype)


def apply_rope(x, positions):
    half = x.shape[-1] // 2
    freqs = ROPE_THETA ** (-jnp.arange(half, dtype=jnp.float32) / half)
    ang = positions.astype(jnp.float32)[:, :, None] * freqs
    cos = jnp.cos(ang)[:, :, None, :]
    sin = jnp.sin(ang)[:, :, None, :]
    xf = x.astype(jnp.float32)
    x1, x2 = xf[..., :half], xf[..., half:]
    return jnp.concatenate([x1 * cos - x2 * sin, x2 * cos + x1 * sin], axis=-1).astype(x.dtype)


def sweep_query_blocks(block_fn, q):
    b, s, h, d = q.shape
    nb = s // Q_BLOCK
    qb = q.reshape(b, nb, Q_BLOCK, h, d).transpose(1, 0, 2, 3, 4)
    out = lax.map(block_fn, (qb, jnp.arange(nb)))
    return out.transpose(1, 0, 2, 3, 4).reshape(b, s, h, out.shape[-1])


def spatial_gating(u, v, ln_g, ln_b, w_s, b_s):
    b, s, _ = v.shape
    v = layer_norm(v, ln_g, ln_b)
    nb = s // SGU_BLOCK
    vb = v.reshape(b, nb, SGU_BLOCK, SGU_GROUPS, SGU_GROUP_DIM)
    pos_chunk = jnp.arange(SGU_BLOCK) // CHUNK
    mask = pos_chunk[None, :] <= pos_chunk[:, None]
    w = jnp.where(mask[None], w_s, jnp.zeros_like(w_s))
    mixed = jnp.einsum('gts,bnsgc->bntgc', w, vb) + b_s.T[None, None, :, :, None]
    return u * mixed.reshape(b, s, SGU_WIDTH)


def multiscale_pool(xb, w_pool, scale):
    b, s, _ = xb.shape
    xf = xb.astype(jnp.float32).reshape(b, s, POOL_GROUPS, POOL_GROUP_DIM)
    cs = jnp.cumsum(xf, axis=1)
    t = jnp.arange(s)
    pooled = []
    for g, win in enumerate(POOL_WINDOWS):
        csg = cs[:, :, g]
        lagged = jnp.pad(csg, ((0, 0), (win, 0), (0, 0)))[:, :s]
        count = jnp.minimum(t + 1, win).astype(jnp.float32)[None, :, None]
        pooled.append((csg - lagged) / count - xf[:, :, g])
    pooled = jnp.stack(pooled, axis=2)
    y = jnp.einsum('bsgc,gcd->bsgd', pooled, w_pool.astype(jnp.float32)).reshape(b, s, POOL_WIDTH)
    return (y * scale.astype(jnp.float32)).astype(xb.dtype)


def latent_attention(c_q, c_kv, c_kr, positions, cq_g, w_uq, ckv_g, w_ukv, qn_g, kn_g):
    b, s, _ = c_q.shape
    q = (rms_norm(c_q, cq_g) @ w_uq).reshape(b, s, MLA_HEADS, MLA_QK)
    kv = (rms_norm(c_kv, ckv_g) @ w_ukv).reshape(b, s, MLA_HEADS, MLA_NOPE + MLA_V)
    k_nope, v = kv[..., :MLA_NOPE], kv[..., MLA_NOPE:]
    k_rope = jnp.broadcast_to(c_kr[:, :, None, :], (b, s, MLA_HEADS, MLA_ROPE))
    k = jnp.concatenate([k_nope, k_rope], axis=-1)
    q = rms_norm(q, qn_g)
    k = rms_norm(k, kn_g)
    q = jnp.concatenate([q[..., :MLA_NOPE], apply_rope(q[..., MLA_NOPE:], positions)], axis=-1)
    k = jnp.concatenate([k[..., :MLA_NOPE], apply_rope(k[..., MLA_NOPE:], positions)], axis=-1)
    qf, kf, vf = q.astype(jnp.float32), k.astype(jnp.float32), v.astype(jnp.float32)
    key_chunk = jnp.arange(s) // CHUNK
    scale = MLA_QK ** -0.5

    def block(args):
        qi, i = args
        sc = jnp.einsum('bqhd,bkhd->bhqk', qi, kf) * scale
        q_chunk = (i * Q_BLOCK + jnp.arange(Q_BLOCK)) // CHUNK
        mask = key_chunk[None, :] <= q_chunk[:, None]
        w = jax.nn.softmax(jnp.where(mask, sc, NEG_INF), axis=-1)
        return jnp.einsum('bhqk,bkhd->bqhd', w, vf)

    o = sweep_query_blocks(block, qf)
    return o.reshape(b, s, MLA_WIDTH).astype(c_q.dtype)


def stick_breaking_attention(q, k, v):
    b, s, _ = q.shape
    qf = q.astype(jnp.float32).reshape(b, s, SB_HEADS, SB_HEAD_DIM)
    kf = k.astype(jnp.float32).reshape(b, s, SB_HEADS, SB_HEAD_DIM)
    vf = v.astype(jnp.float32).reshape(b, s, SB_HEADS, SB_HEAD_DIM)
    key_pos = jnp.arange(s)
    scale = SB_HEAD_DIM ** -0.5

    def block(args):
        qi, i = args
        z = jnp.einsum('bqhd,bkhd->bhqk', qi, kf) * scale
        q_pos = i * Q_BLOCK + jnp.arange(Q_BLOCK)
        strict = key_pos[None, :] < q_pos[:, None]
        log_keep = jnp.where(strict, jax.nn.log_sigmoid(-z), 0.0)
        after = lax.cumsum(log_keep, axis=3, reverse=True) - log_keep
        a = jnp.where(strict, jnp.exp(jax.nn.log_sigmoid(z) + after), 0.0)
        return jnp.einsum('bhqk,bkhd->bqhd', a, vf)

    o = sweep_query_blocks(block, qf)
    return o.reshape(b, s, SB_WIDTH).astype(q.dtype)


def setup_inputs(seed: int = 0) -> dict:
    key = jax.random.key(seed)
    ks = jax.random.split(key, 32)
    f32 = jnp.float32

    def nrm(k, shape, scale):
        return jax.random.normal(k, shape, f32) * scale

    def gain(k, shape):
        return 1.0 + 0.05 * jax.random.normal(k, shape, f32)

    x = jax.random.normal(ks[0], (BATCH, SEQ, D_MODEL), f32)
    p = jax.random.normal(ks[1], (DEPTH, BATCH, SEQ, PLE_DIM), f32)
    offsets = jax.random.randint(ks[2], (BATCH, 1), 0, 4096, dtype=jnp.int32)
    positions = (jnp.arange(SEQ, dtype=jnp.int32)[None, :] + offsets).astype(jnp.int32)
    return {
        'x': x,
        'p': p,
        'positions': positions,
        'norm_g': gain(ks[3], (DEPTH, D_MODEL)),
        'w_in': nrm(ks[4], (DEPTH, D_MODEL, N_IN), D_MODEL ** -0.5),
        'ln_v_g': gain(ks[5], (DEPTH, SGU_WIDTH)),
        'ln_v_b': nrm(ks[6], (DEPTH, SGU_WIDTH), 0.02),
        'sgu_w': nrm(ks[7], (DEPTH, SGU_GROUPS, SGU_BLOCK, SGU_BLOCK), SGU_BLOCK ** -0.5),
        'sgu_b': 1.0 + 0.1 * jax.random.normal(ks[8], (DEPTH, SGU_GROUPS, SGU_BLOCK), f32),
        'w_a_out': nrm(ks[9], (DEPTH, SGU_WIDTH, D_MODEL), SGU_WIDTH ** -0.5),
        'pool_w': nrm(ks[10], (DEPTH, POOL_GROUPS, POOL_GROUP_DIM, POOL_GROUP_DIM), POOL_GROUP_DIM ** -0.5),
        'pool_scale': 1.0 + 0.1 * jax.random.normal(ks[11], (DEPTH, POOL_WIDTH), f32),
        'w_b_out': nrm(ks[12], (DEPTH, POOL_WIDTH, D_MODEL), POOL_WIDTH ** -0.5),
        'cq_norm_g': gain(ks[13], (DEPTH, MLA_Q_RANK)),
        'w_uq': nrm(ks[14], (DEPTH, MLA_Q_RANK, MLA_HEADS * MLA_QK), MLA_Q_RANK ** -0.5),
        'ckv_norm_g': gain(ks[15], (DEPTH, MLA_KV_RANK)),
        'w_ukv': nrm(ks[16], (DEPTH, MLA_KV_RANK, MLA_HEADS * (MLA_NOPE + MLA_V)), MLA_KV_RANK ** -0.5),
        'q_norm_g': gain(ks[17], (DEPTH, MLA_QK)),
        'k_norm_g': gain(ks[18], (DEPTH, MLA_QK)),
        'w_c_out': nrm(ks[19], (DEPTH, MLA_WIDTH, D_MODEL), MLA_WIDTH ** -0.5),
        'w_d_out': nrm(ks[20], (DEPTH, SB_WIDTH, D_MODEL), SB_WIDTH ** -0.5),
        'w_o': nrm(ks[21], (DEPTH, D_MODEL, D_MODEL), D_MODEL ** -0.5),
        'w_ple': nrm(ks[22], (DEPTH, PLE_DIM, D_MODEL), PLE_DIM ** -0.5),
        'ple_norm_g': gain(ks[23], (DEPTH, D_MODEL)),
        'w_ple_gate': nrm(ks[24], (DEPTH, D_MODEL, D_MODEL), D_MODEL ** -0.5),
    }


def reference(x, p, positions, norm_g, w_in, ln_v_g, ln_v_b, sgu_w, sgu_b, w_a_out,
              pool_w, pool_scale, w_b_out, cq_norm_g, w_uq, ckv_norm_g, w_ukv,
              q_norm_g, k_norm_g, w_c_out, w_d_out, w_o, w_ple, ple_norm_g, w_ple_gate):
    b, s, d = x.shape
    split_at = [int(o) for o in np.cumsum(IN_SIZES)[:-1]]
    for i in range(DEPTH):
        h = rms_norm(x, norm_g[i])
        proj = h @ w_in[i]
        (a_u, a_v, a_z, b_x, b_z, c_q, c_kv, c_kr, c_z,
         d_q, d_k, d_v, d_z, gates) = jnp.split(proj, split_at, axis=-1)

        y_a = (spatial_gating(a_u, a_v, ln_v_g[i], ln_v_b[i], sgu_w[i], sgu_b[i])
               * jax.nn.silu(a_z)) @ w_a_out[i]
        y_b = (multiscale_pool(b_x, pool_w[i], pool_scale[i]) * jax.nn.silu(b_z)) @ w_b_out[i]
        y_c = (latent_attention(c_q, c_kv, c_kr, positions, cq_norm_g[i], w_uq[i],
                                ckv_norm_g[i], w_ukv[i], q_norm_g[i], k_norm_g[i])
               * jax.nn.silu(c_z)) @ w_c_out[i]
        y_d = (stick_breaking_attention(d_q, d_k, d_v) * jax.nn.silu(d_z)) @ w_d_out[i]

        g = jax.nn.sigmoid(gates).reshape(b, s, N_BRANCH, d)
        branches = jnp.stack([y_a, y_b, y_c, y_d], axis=2)
        merged = jnp.sum(g * branches, axis=2)
        x = x + merged @ w_o[i]

        e = p[i] @ w_ple[i]
        x = x + jax.nn.sigmoid(rms_norm(x, ple_norm_g[i]) @ w_ple_gate[i]) * e
    return x
```

```cpp
#include <hip/hip_runtime.h>
#include <hip/hip_cooperative_groups.h>
#include <cstdio>
namespace cg = cooperative_groups;

typedef unsigned short u16;
using bf16x8 = __attribute__((ext_vector_type(8))) short;
using f32x4 = __attribute__((ext_vector_type(4))) float;
using i32x4 = __attribute__((ext_vector_type(4))) int;
using u32x2 = __attribute__((ext_vector_type(2))) unsigned;
typedef __bf16 bf16x2_t __attribute__((ext_vector_type(2)));
typedef float f32x2_t __attribute__((ext_vector_type(2)));
#define DI __device__ __forceinline__
#define CBAR() asm volatile("" ::: "memory")
#define MFMA16(a, b, c) __builtin_amdgcn_mfma_f32_16x16x32_bf16((a), (b), (c), 0, 0, 0)

constexpr int T_TOK = 32768, SEQ = 8192, DM = 1024;
constexpr float EPS = 1e-6f;
constexpr size_t MiB = 1u << 20;
constexpr size_t OFF_W = 0, OFF_PB = 32 * MiB, OFF_HB = 48 * MiB, OFF_ACTA = 112 * MiB, OFF_ACTB = 144 * MiB,
                 OFF_ACTC = 176 * MiB, OFF_ACTD = 208 * MiB, OFF_PROJC = 240 * MiB, OFF_QRAW = 272 * MiB,
                 OFF_KC = 320 * MiB, OFF_VTC = 368 * MiB, OFF_PROJD = 400 * MiB, OFF_VTD = 464 * MiB,
                 OFF_ROPE = 496 * MiB, OFF_BAR = 504 * MiB, OFF_PROJA = 400 * MiB, OFF_PROJB = 464 * MiB, OFF_POOLED = 240 * MiB, OFF_MERGED = 272 * MiB;
constexpr size_t W_IN = 0, W_A = 9961472, W_B = W_A + 524288, W_C = W_B + 524288, W_D = W_C + 524288,
                 W_O = W_D + 524288, W_PLE = W_O + 1048576, W_G = W_PLE + 262144, W_UQ = W_G + 1048576,
                 W_UKV = W_UQ + 196608, W_POOL = W_UKV + 131072, W_SGU = W_POOL + 262144;
constexpr int WR_A = 0, WR_B = 1536, WR_C = 2560, WR_D = 3584, WR_GATE = 5632;

struct Params {
  const float* x; const float* p; const int* pos;
  const float *norm_g, *w_in, *ln_v_g, *ln_v_b, *sgu_w, *sgu_b, *w_a_out, *pool_w, *pool_scale, *w_b_out,
      *cq_norm_g, *w_uq, *ckv_norm_g, *w_ukv, *q_norm_g, *k_norm_g, *w_c_out, *w_d_out, *w_o, *w_ple,
      *ple_norm_g, *w_ple_gate;
  float* out; char* ws;
};

DI unsigned pack2(float a, float b) {
  f32x2_t v = {a, b};
  bf16x2_t r = __builtin_convertvector(v, bf16x2_t);
  return __builtin_bit_cast(unsigned, r);
}
DI u16 f2bf(float a) { return (u16)(pack2(a, 0.f) & 0xffffu); }
DI float bf2f(u16 v) { return __uint_as_float(((unsigned)v) << 16); }
DI float bflo(unsigned v) { return __uint_as_float(v << 16); }
DI float bfhi(unsigned v) { return __uint_as_float(v & 0xffff0000u); }
DI float sigmoidf_(float x) { return __builtin_amdgcn_rcpf(1.f + __expf(-x)); }
DI float siluf_(float x) { return x * __builtin_amdgcn_rcpf(1.f + __expf(-x)); }

template <int KS> DI int lds_byte(int r, int c) {
  int st = (r >> 4) * KS + (c >> 5), ob = (r & 15) * 64 + (c & 31) * 2;
  return st * 1024 + (ob ^ (((ob >> 9) & 1) << 5));
}
template <int KS> DI void stage_rc(int b, int& R, int& C) {
  int st = b >> 10, sb = b & 1023, swz = sb ^ (((sb >> 9) & 1) << 5);
  R = (st / KS) * 16 + swz / 64;
  C = (st % KS) * 32 + (swz % 64) / 2;
}

DI int tid_() { int t = threadIdx.x; asm volatile("" : "+v"(t)); return t; }
DI void tile_map(int wgid, int nM, int nN, int& pm, int& pn) {
  const int nwg = nM * nN, q = nwg / 8, r = nwg % 8, xcd = wgid % 8, off = wgid / 8;
  int w2 = (xcd < r ? xcd * (q + 1) : r * (q + 1) + (xcd - r) * q) + off;
  const int WGM = 8;
  int nig = WGM * nN, gid = w2 / nig, fm = gid * WGM, gsz = min(nM - fm, WGM);
  pm = fm + ((w2 % nig) % gsz);
  pn = (w2 % nig) / gsz;
}

template <int MF, int NF, bool SWAP = true>
DI void gemm_main(f32x4 (&acc)[MF][NF], const u16* __restrict__ Ab, int lda, const u16* __restrict__ Bb, int ldb,
                  int K, char* shm) {
  constexpr bool RING3 = (NF == 2);
  constexpr int TILE_A = 32768, STAGE = RING3 ? 49152 : 65536;
  const int tid = tid_(), wid = tid >> 6, lane = tid & 63, wr = wid >> 2, wc = wid & 3, fr = lane & 15,
            fq = lane >> 4;
  constexpr int AL = MF / 2;
  int sR0, sC0;
  stage_rc<2>(wid * 1024 + lane * 16, sR0, sC0);
#pragma unroll
  for (int m = 0; m < MF; ++m)
#pragma unroll
    for (int n = 0; n < NF; ++n) acc[m][n] = f32x4{0.f, 0.f, 0.f, 0.f};
  const int nt = K >> 6;
  const int pa0 = sR0 * lda + sC0, pb0 = sR0 * ldb + sC0;
#define G_STAGE(buf, kt)                                                                                \
  do {                                                                                                  \
    _Pragma("unroll") for (int i = 0; i < AL; ++i) __builtin_amdgcn_global_load_lds(                    \
        (const unsigned*)(Ab + (pa0 + i * 64 * lda + (kt) * 64)), (unsigned*)(shm + (buf) * STAGE + wid * 1024 + i * 8192), 16, 0, 0); \
    _Pragma("unroll") for (int i = 0; i < NF; ++i) __builtin_amdgcn_global_load_lds(                    \
        (const unsigned*)(Bb + (pb0 + i * 64 * ldb + (kt) * 64)), (unsigned*)(shm + (buf) * STAGE + TILE_A + wid * 1024 + i * 8192), 16, 0, 0); \
  } while (0)
  const int a_off = lds_byte<2>(fr, fq * 8) + wr * (MF * 2048);
  const int b_off = lds_byte<2>(fr, fq * 8) + wc * (NF * 2048);
  G_STAGE(0, 0);
  if constexpr (RING3) {
    if (nt > 1) { G_STAGE(1, 1); asm volatile("s_waitcnt vmcnt(6)" ::: "memory"); }
    else asm volatile("s_waitcnt vmcnt(0)" ::: "memory");
    asm volatile("s_waitcnt lgkmcnt(0)" ::: "memory");
    __builtin_amdgcn_s_barrier();
  } else {
    asm volatile("s_waitcnt vmcnt(0)" ::: "memory");
    __syncthreads();
  }
  int cur3 = 0, nxt3 = 2;
#pragma clang loop unroll(disable)
  for (int t = 0; t < nt; ++t) {
    const int cur = RING3 ? cur3 : (t & 1);
    if constexpr (RING3) {
      if (t + 2 < nt) G_STAGE(nxt3, t + 2);
    } else {
      if (t + 1 < nt) G_STAGE(cur ^ 1, t + 1);
    }
    const char* sA = shm + cur * STAGE;
    const char* sB = sA + TILE_A;
    if constexpr (MF == 8 && NF == 4) {
      bf16x8 B0[4], B1[4], A0[4], A1[4], A2[4], A3[4];
#define LDB_(dst, ks) _Pragma("unroll") for (int n = 0; n < 4; ++n) dst[n] = *(const bf16x8*)(sB + b_off + n * 2048 + (ks) * 1024)
#define LDA_(dst, ks, h) _Pragma("unroll") for (int m = 0; m < 4; ++m) dst[m] = *(const bf16x8*)(sA + a_off + ((h) * 4 + m) * 2048 + (ks) * 1024)
#define MMA_(A, B, h) _Pragma("unroll") for (int m = 0; m < 4; ++m) _Pragma("unroll") for (int n = 0; n < 4; ++n) \
      acc[(h) * 4 + m][n] = SWAP ? MFMA16(B[n], A[m], acc[(h) * 4 + m][n]) : MFMA16(A[m], B[n], acc[(h) * 4 + m][n])
      LDB_(B0, 0); LDA_(A0, 0, 0);
      LDA_(A1, 0, 1); MMA_(A0, B0, 0);
      LDB_(B1, 1); LDA_(A2, 1, 0); MMA_(A1, B0, 1);
      LDA_(A3, 1, 1); MMA_(A2, B1, 0);
      MMA_(A3, B1, 1);
#undef LDB_
#undef LDA_
#undef MMA_
      __builtin_amdgcn_sched_group_barrier(0x100, 8, 0);
#pragma unroll
      for (int i = 0; i < 4; ++i) { __builtin_amdgcn_sched_group_barrier(0x100, 1, 0); __builtin_amdgcn_sched_group_barrier(0x008, 4, 0); }
#pragma unroll
      for (int i = 0; i < 8; ++i) { __builtin_amdgcn_sched_group_barrier(0x100, 1, 0); __builtin_amdgcn_sched_group_barrier(0x008, 2, 0); }
#pragma unroll
      for (int i = 0; i < 4; ++i) { __builtin_amdgcn_sched_group_barrier(0x100, 1, 0); __builtin_amdgcn_sched_group_barrier(0x008, 4, 0); }
      __builtin_amdgcn_sched_group_barrier(0x008, 16, 0);
      __builtin_amdgcn_sched_barrier(0);
    } else {
#pragma unroll
    for (int ks = 0; ks < 2; ++ks) {
      bf16x8 Bf[NF];
#pragma unroll
      for (int n = 0; n < NF; ++n) Bf[n] = *(const bf16x8*)(sB + b_off + n * 2048 + ks * 1024);
      constexpr int MG = (NF == 2 && MF == 8) ? 4 : MF;
#pragma unroll
      for (int mg = 0; mg < MF / MG; ++mg) {
        bf16x8 At[MG];
#pragma unroll
        for (int m = 0; m < MG; ++m) At[m] = *(const bf16x8*)(sA + a_off + (mg * MG + m) * 2048 + ks * 1024);
#pragma unroll
        for (int m = 0; m < MG; ++m)
#pragma unroll
          for (int n = 0; n < NF; ++n)
            acc[mg * MG + m][n] = SWAP ? MFMA16(Bf[n], At[m], acc[mg * MG + m][n]) : MFMA16(At[m], Bf[n], acc[mg * MG + m][n]);
        if (mg == 0) __builtin_amdgcn_sched_group_barrier(0x100, MG + NF, 0);
        else __builtin_amdgcn_sched_group_barrier(0x100, MG, 0);
        __builtin_amdgcn_sched_group_barrier(0x008, MG * NF, 0);
        __builtin_amdgcn_sched_barrier(0);
      }
    }
    }
    if constexpr (RING3) {
      if (t + 2 < nt) asm volatile("s_waitcnt vmcnt(6)" ::: "memory");
      else asm volatile("s_waitcnt vmcnt(0)" ::: "memory");
      asm volatile("s_waitcnt lgkmcnt(0)" ::: "memory");
      __builtin_amdgcn_s_barrier();
      cur3 = (cur3 == 2) ? 0 : cur3 + 1;
      nxt3 = (nxt3 == 2) ? 0 : nxt3 + 1;
    } else {
      asm volatile("s_waitcnt vmcnt(0)" ::: "memory");
      __syncthreads();
    }
  }
#undef G_STAGE
}

DI void rowscale_prologue(const u16* Ab, int lda, int K, float* rs) {
  const int tid = tid_(), row = tid >> 1, half = tid & 1;
  const u16* p = Ab + (long)row * lda + half * (K >> 1);
  float ss = 0.f;
  for (int i = 0; i < (K >> 4); ++i) {
    i32x4 v = *(const i32x4*)(p + i * 8);
#pragma unroll
    for (int e = 0; e < 4; ++e) {
      float a = bflo((unsigned)v[e]), b = bfhi((unsigned)v[e]);
      ss += a * a + b * b;
    }
  }
  ss += __shfl_xor(ss, 1);
  if (half == 0) rs[row] = rsqrtf(ss / (float)K + EPS);
  __syncthreads();
}

DI void vt_store(u16* VT, int h, int dv, int row0, f32x4 v) {
  const int b = row0 >> 13, s0 = row0 & 8191;
  const int m32 = s0 >> 5, half = (s0 >> 4) & 1, fq = (s0 >> 2) & 3;
  const int sp = m32 * 32 + fq * 8 + half * 4;
  u32x2 o = {pack2(v[0], v[1]), pack2(v[2], v[3])};
  *(u32x2*)(VT + ((long)((b * 4 + h) * 128 + dv)) * SEQ + sp) = o;
}

struct TJob { const float* src; int ld, K, N, Npad; u16* dst; const float* rs; };
DI TJob get_job(const Params& P, int l, int j, u16* W) {
  TJob t;
  switch (j) {
    case 0: t = TJob{P.w_in + (size_t)l * 1024 * 9664, 9664, 1024, 3008, 3072, W + W_IN, P.norm_g + l * 1024}; break;
    case 1: t = TJob{P.w_in + (size_t)l * 1024 * 9664 + 3008, 9664, 1024, 6656, 6656, W + W_IN + (size_t)3072 * 1024, P.norm_g + l * 1024}; break;
    case 2: t = TJob{P.w_a_out + (size_t)l * 512 * 1024, 1024, 512, 1024, 1024, W + W_A, nullptr}; break;
    case 3: t = TJob{P.w_b_out + (size_t)l * 512 * 1024, 1024, 512, 1024, 1024, W + W_B, nullptr}; break;
    case 4: t = TJob{P.w_c_out + (size_t)l * 512 * 1024, 1024, 512, 1024, 1024, W + W_C, nullptr}; break;
    case 5: t = TJob{P.w_d_out + (size_t)l * 512 * 1024, 1024, 512, 1024, 1024, W + W_D, nullptr}; break;
    case 6: t = TJob{P.w_o + (size_t)l * 1024 * 1024, 1024, 1024, 1024, 1024, W + W_O, nullptr}; break;
    case 7: t = TJob{P.w_ple + (size_t)l * 256 * 1024, 1024, 256, 1024, 1024, W + W_PLE, nullptr}; break;
    case 8: t = TJob{P.w_ple_gate + (size_t)l * 1024 * 1024, 1024, 1024, 1024, 1024, W + W_G, P.ple_norm_g + l * 1024}; break;
    case 9: t = TJob{P.w_uq + (size_t)l * 256 * 768, 768, 256, 768, 768, W + W_UQ, P.cq_norm_g + l * 256}; break;
    default: t = TJob{P.w_ukv + (size_t)l * 128 * 1024, 1024, 128, 1024, 1024, W + W_UKV, P.ckv_norm_g + l * 128}; break;
  }
  return t;
}

DI void phase_prep(const Params& P, int l, char* shm) {
  u16* W = (u16*)(P.ws + OFF_W);
  float* tile = (float*)shm;
  const int tid = tid_();
  constexpr int NT0 = 16 * 48, NT1 = 16 * 104, NTA = 8 * 16, NTO = 16 * 16, NTP = 4 * 16, NTQ = 4 * 12, NTK = 2 * 16;
  constexpr int TOT = NT0 + NT1 + 4 * NTA + NTO + NTP + NTO + NTQ + NTK;
  for (int ft = blockIdx.x; ft < TOT; ft += gridDim.x) {
    int j, tl = ft;
    if (tl < NT0) j = 0;
    else if ((tl -= NT0) < NT1) j = 1;
    else if ((tl -= NT1) < 4 * NTA) { j = 2 + tl / NTA; tl %= NTA; }
    else if ((tl -= 4 * NTA) < NTO) j = 6;
    else if ((tl -= NTO) < NTP) j = 7;
    else if ((tl -= NTP) < NTO) j = 8;
    else if ((tl -= NTO) < NTQ) j = 9;
    else { tl -= NTQ; j = 10; }
    TJob J = get_job(P, l, j, W);
    const int nk = J.K >> 6;
    {
      const int tk = tl % nk, tn = tl / nk;
#pragma unroll
      for (int i = 0; i < 2; ++i) {
        int idx = tid + i * 512, kk = idx >> 4, n4 = (idx & 15) * 4;
        int n = tn * 64 + n4, k = tk * 64 + kk;
        float4 v = make_float4(0.f, 0.f, 0.f, 0.f);
        if (n < J.N) {
          v = *(const float4*)(J.src + (size_t)k * J.ld + n);
          if (J.rs) { float s = J.rs[k]; v.x *= s; v.y *= s; v.z *= s; v.w *= s; }
        }
        float* d = tile + kk * 65 + n4;
        d[0] = v.x; d[1] = v.y; d[2] = v.z; d[3] = v.w;
      }
      __syncthreads();
      {
        int nl = tid >> 3, k8 = (tid & 7) * 8;
        const float* s = tile + k8 * 65 + nl;
        i32x4 o;
        o[0] = (int)pack2(s[0], s[65]);
        o[1] = (int)pack2(s[130], s[195]);
        o[2] = (int)pack2(s[260], s[325]);
        o[3] = (int)pack2(s[390], s[455]);
        *(i32x4*)(J.dst + (size_t)(tn * 64 + nl) * J.K + tk * 64 + k8) = o;
      }
      __syncthreads();
    }
  }
  const int gtid = blockIdx.x * 512 + tid, gn = gridDim.x * 512;
  {
    const float* src = P.sgu_w + (size_t)l * 65536;
    u16* dst = W + W_SGU;
    for (int i = gtid; i < 65536; i += gn) {
      int s = i & 127, t = (i >> 7) & 127;
      dst[i] = ((s >> 6) <= (t >> 6)) ? f2bf(src[i]) : (u16)0;
    }
  }
  {
    const float* pw = P.pool_w + (size_t)l * 65536;
    const float* sc = P.pool_scale + l * 512;
    u16* dst = W + W_POOL;
    for (int i = gtid; i < 262144; i += gn) {
      int n = i >> 9, k = i & 511, g = n >> 7, d = n & 127, g2 = k >> 7, c = k & 127;
      dst[i] = (g == g2) ? f2bf(pw[(g * 128 + c) * 128 + d] * sc[n]) : (u16)0;
    }
  }
  {
    const float* src = P.p + (size_t)l * T_TOK * 256;
    u16* dst = (u16*)(P.ws + OFF_PB);
    for (int i = gtid; i < T_TOK * 256 / 8; i += gn) {
      float4 a = *(const float4*)(src + (size_t)i * 8), b = *(const float4*)(src + (size_t)i * 8 + 4);
      i32x4 o;
      o[0] = (int)pack2(a.x, a.y); o[1] = (int)pack2(a.z, a.w); o[2] = (int)pack2(b.x, b.y); o[3] = (int)pack2(b.z, b.w);
      *(i32x4*)(dst + (size_t)i * 8) = o;
    }
  }
}

DI void phase_rope(const Params& P) {
  float2* tab = (float2*)(P.ws + OFF_ROPE);
  const int gtid = blockIdx.x * 512 + tid_(), gn = gridDim.x * 512;
  for (int i = gtid; i < T_TOK * 32; i += gn) {
    const int t = i >> 5, f = i & 31;
    const float freq = exp2f(-(float)f * (13.287712379549449f / 32.f));
    const float ang = (float)P.pos[t] * freq;
    tab[i] = make_float2(cosf(ang), sinf(ang));
  }
}

DI void phase_norm(const float* xin, u16* hb) {
  const int lane = tid_() & 63, gw = blockIdx.x * 8 + (tid_() >> 6), nw = gridDim.x * 8;
  for (int t = gw; t < T_TOK; t += nw) {
    const float* r = xin + (size_t)t * DM;
    float4 v[4];
    float ss = 0.f;
#pragma unroll
    for (int i = 0; i < 4; ++i) {
      v[i] = *(const float4*)(r + i * 256 + lane * 4);
      ss += v[i].x * v[i].x + v[i].y * v[i].y + v[i].z * v[i].z + v[i].w * v[i].w;
    }
#pragma unroll
    for (int o = 32; o > 0; o >>= 1) ss += __shfl_xor(ss, o);
    const float rs = rsqrtf(ss * (1.f / DM) + EPS);
#pragma unroll
    for (int i = 0; i < 4; ++i) {
      u32x2 o = {pack2(v[i].x * rs, v[i].y * rs), pack2(v[i].z * rs, v[i].w * rs)};
      *(u32x2*)(hb + (size_t)t * DM + i * 256 + lane * 4) = o;
    }
  }
}

template <int MODE>
DI void phase_inproj(const Params& P, char* shm) {
  const u16* hb = (const u16*)(P.ws + OFF_HB);
  const u16* W = (const u16*)(P.ws + OFF_W) + W_IN;
  constexpr int wrow = MODE == 0 ? WR_C : MODE == 1 ? WR_D : MODE == 2 ? WR_A : WR_B;
  constexpr int nN = MODE == 0 ? 4 : MODE == 1 ? 8 : MODE == 2 ? 6 : 4;
  constexpr int SILU0 = MODE == 0 ? 512 : MODE == 1 ? 1536 : MODE == 2 ? 1024 : 512;
  const int tid = tid_(), lane = tid & 63, wid = tid >> 6, wr = wid >> 2, wc = wid & 3, fr = lane & 15, fq = lane >> 4;
  for (int tl = blockIdx.x; tl < 128 * nN; tl += gridDim.x) {
    int pm, pn;
    tile_map(tl, 128, nN, pm, pn);
    const int brow = pm * 256, bcol = pn * 256;
    f32x4 acc[8][4];
    const bool vt = (MODE == 1) && bcol >= 1024 && bcol < 1536;
    const bool silu = bcol >= SILU0;
    if (vt) {
      gemm_main<8, 4, false>(acc, hb + (size_t)brow * DM, DM, W + (size_t)(wrow + bcol) * DM, DM, DM, shm);
#pragma unroll
      for (int m = 0; m < 8; ++m)
#pragma unroll
        for (int n = 0; n < 4; ++n) {
          const int dv = wc * 64 + n * 16 + fr;
          const int p = (wr * 4 + (m >> 1)) * 32 + fq * 8 + (m & 1) * 4;
          u32x2 o = {pack2(acc[m][n][0], acc[m][n][1]), pack2(acc[m][n][2], acc[m][n][3])};
          *(u32x2*)(shm + dv * 528 + p * 2) = o;
        }
    } else {
      gemm_main<8, 4, true>(acc, hb + (size_t)brow * DM, DM, W + (size_t)(wrow + bcol) * DM, DM, DM, shm);
#pragma unroll
      for (int m = 0; m < 8; ++m)
#pragma unroll
        for (int n = 0; n < 4; ++n) {
          const int row = wr * 128 + m * 16 + fr, col = wc * 64 + n * 16 + fq * 4;
          f32x4 v = acc[m][n];
          if (silu) { v[0] = siluf_(v[0]); v[1] = siluf_(v[1]); v[2] = siluf_(v[2]); v[3] = siluf_(v[3]); }
          u32x2 o = {pack2(v[0], v[1]), pack2(v[2], v[3])};
          *(u32x2*)(shm + row * 528 + col * 2) = o;
        }
    }
    __syncthreads();
#pragma unroll 4
    for (int i = 0; i < 16; ++i) {
      const int chunk = tid_() + i * 512, row = chunk >> 5, c8 = (chunk & 31) * 8;
      const i32x4 v = *(const i32x4*)(shm + row * 528 + c8 * 2);
      const int gcol = bcol + c8;
      u16* d = nullptr;
      if (MODE == 0) {
        if (gcol < 448) d = (u16*)(P.ws + OFF_PROJC) + (size_t)(brow + row) * 448 + gcol;
        else if (gcol >= 512) d = (u16*)(P.ws + OFF_ACTC) + (size_t)(brow + row) * 512 + (gcol - 512);
      } else if (MODE == 1) {
        if (gcol < 1024) d = (u16*)(P.ws + OFF_PROJD) + (size_t)(brow + row) * 1024 + gcol;
        else if (gcol < 1536) {
          const int c2 = gcol - c8 - 1024 + row;
          const int b = brow >> 13, s0 = brow & 8191;
          d = (u16*)(P.ws + OFF_VTD) + ((size_t)((b * 4 + (c2 >> 7)) * 128 + (c2 & 127))) * SEQ + s0 + c8;
        } else d = (u16*)(P.ws + OFF_ACTD) + (size_t)(brow + row) * 512 + (gcol - 1536);
      } else if (MODE == 2) {
        if (gcol < 1024) d = (u16*)(P.ws + OFF_PROJA) + (size_t)(brow + row) * 1024 + gcol;
        else d = (u16*)(P.ws + OFF_ACTA) + (size_t)(brow + row) * 512 + (gcol - 1024);
      } else {
        if (gcol < 512) d = (u16*)(P.ws + OFF_PROJB) + (size_t)(brow + row) * 512 + gcol;
        else d = (u16*)(P.ws + OFF_ACTB) + (size_t)(brow + row) * 512 + (gcol - 512);
      }
      if (d) *(i32x4*)d = v;
    }
    __syncthreads();
  }
}

DI void phase_mla_up(const Params& P, int l, char* shm) {
  const u16* projC = (const u16*)(P.ws + OFF_PROJC);
  const float* kng = P.k_norm_g + l * 192;
  const u16* W = (const u16*)(P.ws + OFF_W);
  float* rs = (float*)(shm + 137216);
  const int tid = tid_(), lane = tid & 63, wid = tid >> 6, wr = wid >> 2, wc = wid & 3, fr = lane & 15, fq = lane >> 4;
  for (int tl = blockIdx.x; tl < 128 * 4; tl += gridDim.x) {
    int pm, pn;
    tile_map(tl, 128, 4, pm, pn);
    const int brow = pm * 256, bcol = pn * 256, h = pn;
    const u16* Ab = projC + (size_t)brow * 448 + 256;
    rowscale_prologue(Ab, 448, 128, rs);
    f32x4 acc[8][4];
    gemm_main<8, 4, false>(acc, Ab, 448, W + W_UKV + (size_t)bcol * 128, 128, 128, shm);
#pragma unroll
    for (int m = 0; m < 8; ++m) {
      const int rl = wr * 128 + m * 16 + fq * 4;
      const f32x4 sc = *(const f32x4*)(rs + rl);
#pragma unroll
      for (int n = 0; n < 4; ++n) {
        const f32x4 v = acc[m][n] * sc;
        if (wc < 2) {
          const int col = wc * 64 + n * 16 + fr;
#pragma unroll
          for (int j = 0; j < 4; ++j) *(u16*)(shm + (rl + j) * 272 + col * 2) = f2bf(v[j]);
        } else {
          const int dv = (wc - 2) * 64 + n * 16 + fr;
          const int p = (wr * 4 + (m >> 1)) * 32 + fq * 8 + (m & 1) * 4;
          u32x2 o = {pack2(v[0], v[1]), pack2(v[2], v[3])};
          *(u32x2*)(shm + 69632 + dv * 528 + p * 2) = o;
        }
      }
    }
    __syncthreads();
    {
      const int b = brow >> 13, s0 = brow & 8191;
#pragma unroll 2
      for (int i = 0; i < 8; ++i) {
        const int chunk = tid_() + i * 512, row = chunk >> 4, j16 = chunk & 15, c8 = j16 * 8, t = brow + row;
        const i32x4 v = *(const i32x4*)(shm + row * 272 + c8 * 2);
        const u32x2 krr = *(const u32x2*)(projC + (size_t)t * 448 + 384 + j16 * 4);
        float kv[8], kr[4];
#pragma unroll
        for (int e = 0; e < 4; ++e) { kv[2 * e] = bflo((unsigned)v[e]); kv[2 * e + 1] = bfhi((unsigned)v[e]); }
        kr[0] = bflo(krr[0]); kr[1] = bfhi(krr[0]); kr[2] = bflo(krr[1]); kr[3] = bfhi(krr[1]);
        float ss = 0.f;
#pragma unroll
        for (int e = 0; e < 8; ++e) ss += kv[e] * kv[e];
#pragma unroll
        for (int e = 0; e < 4; ++e) ss += kr[e] * kr[e];
        ss += __shfl_xor(ss, 1); ss += __shfl_xor(ss, 2); ss += __shfl_xor(ss, 4); ss += __shfl_xor(ss, 8);
        const float r = rsqrtf(ss * (1.f / 192.f) + EPS);
        u16* kd = (u16*)(P.ws + OFF_KC) + ((size_t)((b * 4 + h) * SEQ + s0 + row)) * 192;
        const f32x4 g0 = *(const f32x4*)(kng + c8), g1 = *(const f32x4*)(kng + c8 + 4);
        i32x4 o;
        o[0] = (int)pack2(kv[0] * r * g0[0], kv[1] * r * g0[1]);
        o[1] = (int)pack2(kv[2] * r * g0[2], kv[3] * r * g0[3]);
        o[2] = (int)pack2(kv[4] * r * g1[0], kv[5] * r * g1[1]);
        o[3] = (int)pack2(kv[6] * r * g1[2], kv[7] * r * g1[3]);
        *(i32x4*)(kd + c8) = o;
        const f32x4 gr = *(const f32x4*)(kng + 128 + j16 * 4);
        const f32x4* rt = (const f32x4*)(P.ws + OFF_ROPE) + (size_t)t * 16 + (j16 & 7) * 2;
        const f32x4 cs01 = rt[0], cs23 = rt[1];
        float my[4], ot[4], rv[4];
#pragma unroll
        for (int e = 0; e < 4; ++e) { my[e] = kr[e] * r * gr[e]; ot[e] = __shfl_xor(my[e], 8); }
        const float sgn = (j16 < 8) ? -1.f : 1.f;
        rv[0] = my[0] * cs01[0] + sgn * ot[0] * cs01[1];
        rv[1] = my[1] * cs01[2] + sgn * ot[1] * cs01[3];
        rv[2] = my[2] * cs23[0] + sgn * ot[2] * cs23[1];
        rv[3] = my[3] * cs23[2] + sgn * ot[3] * cs23[3];
        u32x2 ro = {pack2(rv[0], rv[1]), pack2(rv[2], rv[3])};
        *(u32x2*)(kd + 128 + j16 * 4) = ro;
      }
#pragma unroll 4
      for (int i = 0; i < 8; ++i) {
        const int chunk = tid_() + i * 512, dv = chunk >> 5, c8 = (chunk & 31) * 8;
        const i32x4 v = *(const i32x4*)(shm + 69632 + dv * 528 + c8 * 2);
        *(i32x4*)((u16*)(P.ws + OFF_VTC) + ((size_t)((b * 4 + h) * 128 + dv)) * SEQ + s0 + c8) = v;
      }
    }
    __syncthreads();
  }
  for (int tl = blockIdx.x; tl < 128 * 3; tl += gridDim.x) {
    int pm, pn;
    tile_map(tl, 128, 3, pm, pn);
    const int brow = pm * 256, bcol = pn * 256;
    const u16* Ab = projC + (size_t)brow * 448;
    rowscale_prologue(Ab, 448, 256, rs);
    f32x4 acc[8][4];
    gemm_main<8, 4>(acc, Ab, 448, W + W_UQ + (size_t)bcol * 256, 256, 256, shm);
#pragma unroll
    for (int m = 0; m < 8; ++m) {
      const int rl = wr * 128 + m * 16 + fr;
      const float sc = rs[rl];
#pragma unroll
      for (int n = 0; n < 4; ++n) {
        const int col = wc * 64 + n * 16 + fq * 4;
        const f32x4 v = acc[m][n] * sc;
        u32x2 o = {pack2(v[0], v[1]), pack2(v[2], v[3])};
        *(u32x2*)(shm + rl * 528 + col * 2) = o;
      }
    }
    __syncthreads();
#pragma unroll 4
    for (int i = 0; i < 16; ++i) {
      const int chunk = tid_() + i * 512, row = chunk >> 5, c8 = (chunk & 31) * 8;
      const i32x4 v = *(const i32x4*)(shm + row * 528 + c8 * 2);
      *(i32x4*)((u16*)(P.ws + OFF_QRAW) + (size_t)(brow + row) * 768 + bcol + c8) = v;
    }
    __syncthreads();
  }
}

DI void phase_kprep(const Params& P, int l, int dry = 0) {
  const int lane = tid_() & 63, gw = blockIdx.x * 8 + (tid_() >> 6), nw = gridDim.x * 8;
  const float* g = P.k_norm_g + l * 192;
  const u16* projC = (const u16*)(P.ws + OFF_PROJC);
  u16* Kc = (u16*)(P.ws + OFF_KC);
  const float g0 = g[2 * lane], g1 = g[2 * lane + 1];
  const float gr1 = g[128 + (lane & 31)], gr2 = g[160 + (lane & 31)];
  for (int it = gw; it < T_TOK * 4; it += nw) {
    const int t = it >> 2, h = it & 3, b = t >> 13, s = t & 8191;
    u16* kr = Kc + ((size_t)((b * 4 + h) * SEQ + s)) * 192;
    const unsigned kv = *(const unsigned*)(kr + 2 * lane);
    float v0 = bflo(kv), v1 = bfhi(kv);
    float r1 = 0.f, r2 = 0.f;
    if (lane < 32) {
      r1 = bf2f(projC[(size_t)t * 448 + 384 + lane]);
      r2 = bf2f(projC[(size_t)t * 448 + 416 + lane]);
    }
    float ss = v0 * v0 + v1 * v1 + r1 * r1 + r2 * r2;
#pragma unroll
    for (int o = 32; o > 0; o >>= 1) ss += __shfl_xor(ss, o);
    const float r = rsqrtf(ss * (1.f / 192.f) + EPS);
    if (!dry) *(unsigned*)(kr + 2 * lane) = pack2(v0 * r * g0, v1 * r * g1);
    if (lane < 32 && !dry) {
      const float2 cssn = ((const float2*)(P.ws + OFF_ROPE))[(size_t)t * 32 + lane];
      const float cs = cssn.x, sn = cssn.y;
      const float x1 = r1 * r * gr1, x2 = r2 * r * gr2;
      kr[128 + lane] = f2bf(x1 * cs - x2 * sn);
      kr[160 + lane] = f2bf(x2 * cs + x1 * sn);
    }
  }
}

DI void phase_attn_d(const Params& P, char* shm, int dry = 0) {
  constexpr int KT_B = 16384, VT_B = 16384, BUF_B = KT_B + VT_B;
  const int tid = tid_();
  const int wid = __builtin_amdgcn_readfirstlane(tid >> 6), lane = tid & 63, fr = lane & 15, fq = lane >> 4;
  const u16* projD = (const u16*)(P.ws + OFF_PROJD);
  const u16* VT = (const u16*)(P.ws + OFF_VTD);
  u16* actD = (u16*)(P.ws + OFF_ACTD);
  volatile int* sdone = (volatile int*)(shm + 2 * BUF_B);
  const float sc = 0.08838834764831845f;
  int kR[2], kC[2], vR[2], vC[2];
#pragma unroll
  for (int i = 0; i < 2; ++i) {
    stage_rc<4>((tid + i * 512) * 16, kR[i], kC[i]);
    stage_rc<2>((tid + i * 512) * 16, vR[i], vC[i]);
  }
  int pk[2], pv[2];
#pragma unroll
  for (int i = 0; i < 2; ++i) { pk[i] = kR[i] * 1024 + kC[i]; pv[i] = vR[i] * SEQ + vC[i]; }
  const int kf_off = lds_byte<4>(fr, fq * 8), vf_off = lds_byte<2>(fr, fq * 8);
  for (int it = blockIdx.x; it < 16 * 64; it += gridDim.x) {
    const int bh = it >> 6, qb = it & 63, b = bh >> 2, h = bh & 3, T0 = qb * 128, t0 = T0 + wid * 16;
    const u16* Kg = projD + (size_t)(b * SEQ) * 1024 + 512 + h * 128;
    const u16* Vg = VT + (size_t)(bh * 128) * SEQ;
#define D_STAGE(buf, kb_)                                                                                  \
  do {                                                                                                     \
    _Pragma("unroll") for (int i = 0; i < 2; ++i) __builtin_amdgcn_global_load_lds(                        \
        (const unsigned*)(Kg + (pk[i] + (kb_) * 1024)), (unsigned*)(shm + (buf) * BUF_B + wid * 1024 + i * 8192), 16, 0, 0); \
    _Pragma("unroll") for (int i = 0; i < 2; ++i) __builtin_amdgcn_global_load_lds(                        \
        (const unsigned*)(Vg + (pv[i] + (kb_))), (unsigned*)(shm + (buf) * BUF_B + KT_B + wid * 1024 + i * 8192), 16, 0, 0); \
  } while (0)
    const int kb_top = T0 + 64;
    D_STAGE(0, kb_top);
    const u16* qp = projD + (size_t)(b * SEQ + t0 + fr) * 1024 + h * 128 + fq * 8;
    bf16x8 qf[4];
#pragma unroll
    for (int ks = 0; ks < 4; ++ks) qf[ks] = *(const bf16x8*)(qp + ks * 32);
    f32x4 o[8];
#pragma unroll
    for (int i = 0; i < 8; ++i) o[i] = f32x4{0.f, 0.f, 0.f, 0.f};
    float R = 0.f;
    const int tq = t0 + fr;
    const int kbw = (t0 >> 6) << 6;
    int done = 0;
    asm volatile("s_waitcnt vmcnt(0)" ::: "memory");
    __syncthreads();
    int iter = 0;
#pragma clang loop unroll(disable)
    for (int kb = kb_top;; kb -= 64, ++iter) {
      const int cur = iter & 1;
      const bool more = kb >= 64;
      if (more) D_STAGE(cur ^ 1, kb - 64);
      if (!done && kb <= kbw) {
        const char* Kf = shm + cur * BUF_B + kf_off;
        const char* Vf = shm + cur * BUF_B + KT_B + vf_off;
        f32x4 z[4];
#pragma unroll
        for (int sub = 0; sub < 4; ++sub) {
          z[sub] = f32x4{0.f, 0.f, 0.f, 0.f};
#pragma unroll
          for (int ks = 0; ks < 4; ++ks) {
            const bf16x8 kf = *(const bf16x8*)(Kf + sub * 4096 + ks * 1024);
            z[sub] = MFMA16(kf, qf[ks], z[sub]);
          }
        }
        float lk[4][4], lz[4][4], loc[4];
#pragma unroll
        for (int sub = 0; sub < 4; ++sub) {
          loc[sub] = 0.f;
#pragma unroll
          for (int j = 0; j < 4; ++j) {
            const int key = kb + sub * 16 + fq * 4 + j;
            const bool valid = key < tq;
            const float zv = z[sub][j] * sc;
            const float sp = fmaxf(zv, 0.f) + __logf(1.f + __expf(-fabsf(zv)));
            lk[sub][j] = valid ? -sp : 0.f;
            lz[sub][j] = valid ? (zv - sp) : -1e30f;
            loc[sub] += lk[sub][j];
          }
        }
        float run = R;
        float a[4][4];
#pragma unroll
        for (int sub = 3; sub >= 0; --sub) {
          const float p = __shfl_xor(loc[sub], 16);
          const float pr = loc[sub] + p;
          const float c = __shfl_xor(pr, 32);
          const float suf_in = (fq == 3) ? 0.f : (fq == 2) ? p : (fq == 1) ? c : (p + c);
          float af = run + suf_in;
#pragma unroll
          for (int j = 3; j >= 0; --j) {
            a[sub][j] = __expf(lz[sub][j] + af);
            af += lk[sub][j];
          }
          run += pr + c;
        }
        R = run;
        bf16x8 pf[2];
#pragma unroll
        for (int kk = 0; kk < 2; ++kk) {
          i32x4 pkk;
          pkk[0] = (int)pack2(a[2 * kk][0], a[2 * kk][1]);
          pkk[1] = (int)pack2(a[2 * kk][2], a[2 * kk][3]);
          pkk[2] = (int)pack2(a[2 * kk + 1][0], a[2 * kk + 1][1]);
          pkk[3] = (int)pack2(a[2 * kk + 1][2], a[2 * kk + 1][3]);
          pf[kk] = __builtin_bit_cast(bf16x8, pkk);
        }
#pragma unroll
        for (int dvs = 0; dvs < 8; ++dvs) {
          const bf16x8 v0 = *(const bf16x8*)(Vf + dvs * 2048);
          const bf16x8 v1 = *(const bf16x8*)(Vf + dvs * 2048 + 1024);
          o[dvs] = MFMA16(v0, pf[0], o[dvs]);
          o[dvs] = MFMA16(v1, pf[1], o[dvs]);
        }
        if (__all(R < -104.f)) done = 1;
      }
      if (lane == 0) sdone[cur * 8 + wid] = done;
      asm volatile("s_waitcnt vmcnt(0)" ::: "memory");
      __syncthreads();
      int alld = 1;
#pragma unroll
      for (int w = 0; w < 8; ++w) alld &= sdone[cur * 8 + w];
      if (alld || !more) break;
    }
#undef D_STAGE
    u16* dp = actD + (size_t)(b * SEQ + t0 + fr) * 512 + h * 128 + fq * 4;
#pragma unroll
    for (int dvs = 0; dvs < 8; ++dvs) {
      u32x2 gz = *(const u32x2*)(dp + dvs * 16);
      u32x2 ov = {pack2(o[dvs][0] * bflo(gz[0]), o[dvs][1] * bfhi(gz[0])),
                  pack2(o[dvs][2] * bflo(gz[1]), o[dvs][3] * bfhi(gz[1]))};
      if (!dry) *(u32x2*)(dp + dvs * 16) = ov;
    }
    __syncthreads();
  }
}

DI void attn_c_item(const Params& P, int l, int b, int h, int qb, char* shm, float B2, int dry) {
  const int tid = tid_();
  const int wid = __builtin_amdgcn_readfirstlane(tid >> 6), lane = tid & 63, fr = lane & 15, fq = lane >> 4;
  const u16* Kg = (const u16*)(P.ws + OFF_KC) + (size_t)((b * 4 + h) * SEQ) * 192;
  const u16* Vg = (const u16*)(P.ws + OFF_VTC) + (size_t)((b * 4 + h) * 128) * SEQ;
  const u16* qraw = (const u16*)(P.ws + OFF_QRAW);
  const float* qg = P.q_norm_g + l * 192;
  const int q0 = qb * 256 + wid * 32;
  bf16x8 qf[2][6];
  const float qscale = 0.07216878364870323f * 1.4426950408889634f;
#pragma unroll
  for (int qs = 0; qs < 2; ++qs) {
    const int t = b * SEQ + q0 + qs * 16 + fr;
    const u16* qp = qraw + (size_t)t * 768 + h * 192 + fq * 8;
    float v[6][8];
    float ss = 0.f;
#pragma unroll
    for (int ks = 0; ks < 6; ++ks) {
      i32x4 raw = *(const i32x4*)(qp + ks * 32);
#pragma unroll
      for (int e = 0; e < 4; ++e) {
        v[ks][2 * e] = bflo((unsigned)raw[e]);
        v[ks][2 * e + 1] = bfhi((unsigned)raw[e]);
        ss += v[ks][2 * e] * v[ks][2 * e] + v[ks][2 * e + 1] * v[ks][2 * e + 1];
      }
    }
    ss += __shfl_xor(ss, 16);
    ss += __shfl_xor(ss, 32);
    const float r = rsqrtf(ss * (1.f / 192.f) + EPS);
#pragma unroll
    for (int ks = 0; ks < 6; ++ks)
#pragma unroll
      for (int e = 0; e < 8; ++e) v[ks][e] *= r * qg[ks * 32 + fq * 8 + e];
    const f32x4* rt = (const f32x4*)(P.ws + OFF_ROPE) + (size_t)t * 16 + fq * 4;
#pragma unroll
    for (int e2 = 0; e2 < 4; ++e2) {
      const f32x4 cssn = rt[e2];
#pragma unroll
      for (int u = 0; u < 2; ++u) {
        const int e = e2 * 2 + u;
        const float cs = cssn[2 * u], sn = cssn[2 * u + 1];
        const float x1 = v[4][e], x2 = v[5][e];
        v[4][e] = x1 * cs - x2 * sn;
        v[5][e] = x2 * cs + x1 * sn;
      }
    }
#pragma unroll
    for (int ks = 0; ks < 6; ++ks) {
      i32x4 pk;
#pragma unroll
      for (int e = 0; e < 4; ++e) pk[e] = (int)pack2(v[ks][2 * e] * qscale, v[ks][2 * e + 1] * qscale);
      qf[qs][ks] = __builtin_bit_cast(bf16x8, pk);
    }
  }
  constexpr int KT_B = 24576, VT_B = 16384, BUF_B = KT_B + VT_B;
  const int ntile = qb * 4 + 4;
  const int my_last = qb * 4 + (wid >> 1);
  f32x4 o[8][2];
#pragma unroll
  for (int i = 0; i < 8; ++i) { o[i][0] = f32x4{0.f, 0.f, 0.f, 0.f}; o[i][1] = f32x4{0.f, 0.f, 0.f, 0.f}; }
  float lsum[2] = {0.f, 0.f};
  int kR[3], kC[3], vR[2], vC[2];
#pragma unroll
  for (int i = 0; i < 3; ++i) stage_rc<6>((tid + i * 512) * 16, kR[i], kC[i]);
#pragma unroll
  for (int i = 0; i < 2; ++i) stage_rc<2>((tid + i * 512) * 16, vR[i], vC[i]);
  int pk[3], pv[2];
#pragma unroll
  for (int i = 0; i < 3; ++i) pk[i] = kR[i] * 192 + kC[i];
#pragma unroll
  for (int i = 0; i < 2; ++i) pv[i] = vR[i] * SEQ + vC[i];
#define A_STAGE(buf, kt)                                                                                 \
  do {                                                                                                   \
    _Pragma("unroll") for (int i = 0; i < 3; ++i) __builtin_amdgcn_global_load_lds(                      \
        (const unsigned*)(Kg + (pk[i] + (kt) * 64 * 192)), (unsigned*)(shm + (buf) * BUF_B + wid * 1024 + i * 8192), 16, 0, 0); \
    _Pragma("unroll") for (int i = 0; i < 2; ++i) __builtin_amdgcn_global_load_lds(                      \
        (const unsigned*)(Vg + (pv[i] + (kt) * 64)), (unsigned*)(shm + (buf) * BUF_B + KT_B + wid * 1024 + i * 8192), 16, 0, 0); \
  } while (0)
  A_STAGE(0, 0);
  asm volatile("s_waitcnt vmcnt(0)" ::: "memory");
  __syncthreads();
#pragma clang loop unroll(disable)
  for (int kt = 0; kt < ntile; ++kt) {
    const int cur = kt & 1;
    if (kt + 1 < ntile) A_STAGE(cur ^ 1, kt + 1);
    if (kt <= my_last) {
      const char* Kb = shm + cur * BUF_B;
      const char* Vb = Kb + KT_B;
      f32x4 s[4][2];
#pragma unroll
      for (int i = 0; i < 4; ++i) { s[i][0] = f32x4{0.f, 0.f, 0.f, 0.f}; s[i][1] = f32x4{0.f, 0.f, 0.f, 0.f}; }
      const char* Kf = Kb + lds_byte<6>(fr, fq * 8);
      const char* Vf = Vb + lds_byte<2>(fr, fq * 8);
      bf16x8 kf[2][4], vf0[8], vf1[8];
#pragma unroll
      for (int sub = 0; sub < 4; ++sub) kf[0][sub] = *(const bf16x8*)(Kf + sub * 6144);
#pragma unroll
      for (int ks = 0; ks < 6; ++ks) {
        if (ks < 5) {
#pragma unroll
          for (int sub = 0; sub < 4; ++sub) kf[(ks + 1) & 1][sub] = *(const bf16x8*)(Kf + sub * 6144 + (ks + 1) * 1024);
        } else {
#pragma unroll
          for (int dvs = 0; dvs < 8; ++dvs) vf0[dvs] = *(const bf16x8*)(Vf + dvs * 2048);
        }
#pragma unroll
        for (int sub = 0; sub < 4; ++sub) {
          s[sub][0] = MFMA16(kf[ks & 1][sub], qf[0][ks], s[sub][0]);
          s[sub][1] = MFMA16(kf[ks & 1][sub], qf[1][ks], s[sub][1]);
        }
      }
      __builtin_amdgcn_sched_group_barrier(0x100, 4, 0);
#pragma unroll
      for (int i = 0; i < 20; ++i) { __builtin_amdgcn_sched_group_barrier(0x100, 1, 0); __builtin_amdgcn_sched_group_barrier(0x008, 2, 0); }
#pragma unroll
      for (int i = 0; i < 4; ++i) { __builtin_amdgcn_sched_group_barrier(0x100, 2, 0); __builtin_amdgcn_sched_group_barrier(0x008, 2, 0); }
      __builtin_amdgcn_sched_barrier(0);
      bf16x8 pf[2][2];
#pragma unroll
      for (int qs = 0; qs < 2; ++qs) {
#pragma unroll
        for (int kk = 0; kk < 2; ++kk) {
          float pv[8];
#pragma unroll
          for (int j = 0; j < 4; ++j) {
            pv[j] = __builtin_amdgcn_exp2f(s[2 * kk][qs][j] - B2);
            pv[4 + j] = __builtin_amdgcn_exp2f(s[2 * kk + 1][qs][j] - B2);
          }
          lsum[qs] += ((pv[0] + pv[1]) + (pv[2] + pv[3])) + ((pv[4] + pv[5]) + (pv[6] + pv[7]));
          i32x4 pk;
#pragma unroll
          for (int e = 0; e < 4; ++e) pk[e] = (int)pack2(pv[2 * e], pv[2 * e + 1]);
          pf[kk][qs] = __builtin_bit_cast(bf16x8, pk);
        }
      }
      __builtin_amdgcn_sched_barrier(0);
#pragma unroll
      for (int dvs = 0; dvs < 8; ++dvs) vf1[dvs] = *(const bf16x8*)(Vf + dvs * 2048 + 1024);
#pragma unroll
      for (int dvs = 0; dvs < 8; ++dvs) {
        o[dvs][0] = MFMA16(vf0[dvs], pf[0][0], o[dvs][0]);
        o[dvs][1] = MFMA16(vf0[dvs], pf[0][1], o[dvs][1]);
      }
#pragma unroll
      for (int dvs = 0; dvs < 8; ++dvs) {
        o[dvs][0] = MFMA16(vf1[dvs], pf[1][0], o[dvs][0]);
        o[dvs][1] = MFMA16(vf1[dvs], pf[1][1], o[dvs][1]);
      }
#pragma unroll
      for (int i = 0; i < 8; ++i) { __builtin_amdgcn_sched_group_barrier(0x100, 1, 0); __builtin_amdgcn_sched_group_barrier(0x008, 2, 0); }
      __builtin_amdgcn_sched_group_barrier(0x008, 16, 0);
      __builtin_amdgcn_sched_barrier(0);
    }
    asm volatile("s_waitcnt vmcnt(0)" ::: "memory");
    __syncthreads();
  }
#undef A_STAGE
  u16* actC = (u16*)(P.ws + OFF_ACTC);
#pragma unroll
  for (int qs = 0; qs < 2; ++qs) {
    float lt = lsum[qs];
    lt += __shfl_xor(lt, 16);
    lt += __shfl_xor(lt, 32);
    const float inv = 1.f / lt;
    u16* dp = actC + (size_t)(b * SEQ + q0 + qs * 16 + fr) * 512 + h * 128 + fq * 4;
#pragma unroll
    for (int dvs = 0; dvs < 8; ++dvs) {
      u32x2 gz = *(const u32x2*)(dp + dvs * 16);
      u32x2 ov = {pack2(o[dvs][qs][0] * inv * bflo(gz[0]), o[dvs][qs][1] * inv * bfhi(gz[0])),
                  pack2(o[dvs][qs][2] * inv * bflo(gz[1]), o[dvs][qs][3] * inv * bfhi(gz[1]))};
      if (!dry) *(u32x2*)(dp + dvs * 16) = ov;
    }
  }
}

DI void phase_attn_c(const Params& P, int l, char* shm, int dry) {
  const int lane = tid_() & 63;
  float gq = 0.f, gk = 0.f;
#pragma unroll
  for (int i = 0; i < 3; ++i) {
    gq = fmaxf(gq, fabsf(P.q_norm_g[l * 192 + lane + i * 64]));
    gk = fmaxf(gk, fabsf(P.k_norm_g[l * 192 + lane + i * 64]));
  }
#pragma unroll
  for (int o = 32; o > 0; o >>= 1) { gq = fmaxf(gq, __shfl_xor(gq, o)); gk = fmaxf(gk, __shfl_xor(gk, o)); }
  const float B2 = 13.856406460551018f * 1.4426950408889634f * gq * gk;
  for (int it = blockIdx.x; it < 256; it += gridDim.x) {
    const int bh = it >> 4, pr = it & 15, b = bh >> 2, h = bh & 3;
#pragma clang loop unroll(disable)
    for (int hf = 0; hf < 2; ++hf) attn_c_item(P, l, b, h, hf ? pr : 31 - pr, shm, B2, dry);
  }
}

DI void phase_sgu(const Params& P, int l, char* shm, int dry = 0) {
  const int tid = tid_(), wid = tid >> 6, lane = tid & 63, fr = lane & 15, fq = lane >> 4;
  u16* vT = (u16*)shm;
  float* st = (float*)(shm + 128 * 136 * 2);
  const u16* projA = (const u16*)(P.ws + OFF_PROJA);
  u16* actA = (u16*)(P.ws + OFF_ACTA);
  const u16* Wsgu = (const u16*)(P.ws + OFF_W) + W_SGU;
  const float* lng = P.ln_v_g + l * 512;
  const float* lnb = P.ln_v_b + l * 512;
  const float* sb = P.sgu_b + l * 512;
  for (int nb = blockIdx.x; nb < 256; nb += gridDim.x) {
    const int T0 = nb * 128;
    {
      const int tok = tid >> 2, qu = tid & 3;
      const u16* p = projA + (size_t)(T0 + tok) * 1024 + 512 + qu * 128;
      float s1 = 0.f, s2 = 0.f;
#pragma unroll
      for (int i = 0; i < 16; ++i) {
        i32x4 v = *(const i32x4*)(p + i * 8);
#pragma unroll
        for (int e = 0; e < 4; ++e) {
          float a = bflo((unsigned)v[e]), c = bfhi((unsigned)v[e]);
          s1 += a + c;
          s2 += a * a + c * c;
        }
      }
      s1 += __shfl_xor(s1, 1); s2 += __shfl_xor(s2, 1);
      s1 += __shfl_xor(s1, 2); s2 += __shfl_xor(s2, 2);
      const float mean = s1 * (1.f / 512.f);
      const float var = fmaxf(s2 * (1.f / 512.f) - mean * mean, 0.f);
      if (qu == 0) { st[tok] = mean; st[128 + tok] = rsqrtf(var + EPS); }
    }
    __syncthreads();
    for (int g = 0; g < 4; ++g) {
      {
        const int s = tid >> 2, cq = tid & 3;
        const float mean = st[s], rstd = st[128 + s];
        const u16* p = projA + (size_t)(T0 + s) * 1024 + 512 + g * 128 + cq * 32;
#pragma unroll
        for (int i = 0; i < 4; ++i) {
          i32x4 v = *(const i32x4*)(p + i * 8);
#pragma unroll
          for (int e = 0; e < 4; ++e) {
            const int c = cq * 32 + i * 8 + 2 * e;
            float a = (bflo((unsigned)v[e]) - mean) * rstd * lng[g * 128 + c] + lnb[g * 128 + c];
            float d = (bfhi((unsigned)v[e]) - mean) * rstd * lng[g * 128 + c + 1] + lnb[g * 128 + c + 1];
            vT[c * 136 + s] = f2bf(a);
            vT[(c + 1) * 136 + s] = f2bf(d);
          }
        }
      }
      __syncthreads();
      f32x4 acc[8];
#pragma unroll
      for (int i = 0; i < 8; ++i) acc[i] = f32x4{0.f, 0.f, 0.f, 0.f};
      const u16* wp = Wsgu + (size_t)(g * 128 + wid * 16 + fr) * 128 + fq * 8;
#pragma unroll
      for (int ks = 0; ks < 4; ++ks) {
        bf16x8 af = *(const bf16x8*)(wp + ks * 32);
#pragma unroll
        for (int ns = 0; ns < 8; ++ns) {
          bf16x8 bfr = *(const bf16x8*)(vT + (ns * 16 + fr) * 136 + ks * 32 + fq * 8);
          acc[ns] = MFMA16(bfr, af, acc[ns]);
        }
      }
      {
        const int tl = wid * 16 + fr;
        const float bias = sb[g * 128 + tl];
        float* mx = (float*)(shm + 36864);
#pragma unroll
        for (int ns = 0; ns < 8; ++ns) {
          f32x4 v = acc[ns];
          v[0] += bias; v[1] += bias; v[2] += bias; v[3] += bias;
          *(f32x4*)(mx + tl * 132 + ns * 16 + fq * 4) = v;
        }
      }
      __syncthreads();
      {
        const float* mx = (const float*)(shm + 36864);
#pragma unroll
        for (int i = 0; i < 4; ++i) {
          const int chunk = tid + i * 512, tl = chunk >> 4, c8 = (chunk & 15) * 8, tt = T0 + tl;
          const f32x4 m0 = *(const f32x4*)(mx + tl * 132 + c8), m1 = *(const f32x4*)(mx + tl * 132 + c8 + 4);
          const i32x4 u = *(const i32x4*)(projA + (size_t)tt * 1024 + g * 128 + c8);
          u16* d = actA + (size_t)tt * 512 + g * 128 + c8;
          const i32x4 zg = *(const i32x4*)d;
          i32x4 o;
          o[0] = (int)pack2(bflo((unsigned)u[0]) * m0[0] * bflo((unsigned)zg[0]), bfhi((unsigned)u[0]) * m0[1] * bfhi((unsigned)zg[0]));
          o[1] = (int)pack2(bflo((unsigned)u[1]) * m0[2] * bflo((unsigned)zg[1]), bfhi((unsigned)u[1]) * m0[3] * bfhi((unsigned)zg[1]));
          o[2] = (int)pack2(bflo((unsigned)u[2]) * m1[0] * bflo((unsigned)zg[2]), bfhi((unsigned)u[2]) * m1[1] * bfhi((unsigned)zg[2]));
          o[3] = (int)pack2(bflo((unsigned)u[3]) * m1[2] * bflo((unsigned)zg[3]), bfhi((unsigned)u[3]) * m1[3] * bfhi((unsigned)zg[3]));
          if (!dry) *(i32x4*)d = o;
        }
      }
      __syncthreads();
    }
  }
}

DI void phase_pooled(const Params& P) {
  const u16* projB = (const u16*)(P.ws + OFF_PROJB);
  u16* pooled = (u16*)(P.ws + OFF_POOLED);
  const int gtid = blockIdx.x * 512 + tid_(), gn = gridDim.x * 512;
  for (int it = gtid; it < (T_TOK / 16) * 64; it += gn) {
    const int seg = it >> 6, c8 = it & 63, g = c8 >> 4, win = 2 << g, t0 = seg * 16, s0 = t0 & 8191;
    const u16* base = projB + (size_t)t0 * 512 + c8 * 8;
    float run[8];
#pragma unroll
    for (int e = 0; e < 8; ++e) run[e] = 0.f;
    for (int j = 1; j < win; ++j) {
      if (s0 - j >= 0) {
        const i32x4 v = *(const i32x4*)(base - (size_t)j * 512);
#pragma unroll
        for (int e = 0; e < 4; ++e) { run[2 * e] += bflo((unsigned)v[e]); run[2 * e + 1] += bfhi((unsigned)v[e]); }
      }
    }
#pragma unroll 4
    for (int i = 0; i < 16; ++i) {
      const i32x4 v = *(const i32x4*)(base + (size_t)i * 512);
      float x0[8];
#pragma unroll
      for (int e = 0; e < 4; ++e) {
        x0[2 * e] = bflo((unsigned)v[e]); x0[2 * e + 1] = bfhi((unsigned)v[e]);
        run[2 * e] += x0[2 * e]; run[2 * e + 1] += x0[2 * e + 1];
      }
      const int s = s0 + i;
      const float inv = 1.f / (float)min(s + 1, win);
      i32x4 o;
#pragma unroll
      for (int e = 0; e < 4; ++e) o[e] = (int)pack2(run[2 * e] * inv - x0[2 * e], run[2 * e + 1] * inv - x0[2 * e + 1]);
      *(i32x4*)(pooled + (size_t)(t0 + i) * 512 + c8 * 8) = o;
      if (s - win + 1 >= 0) {
        const i32x4 w = *(const i32x4*)(base + (size_t)(i - win + 1) * 512);
#pragma unroll
        for (int e = 0; e < 4; ++e) { run[2 * e] -= bflo((unsigned)w[e]); run[2 * e + 1] -= bfhi((unsigned)w[e]); }
      }
    }
  }
}

DI void phase_pool_gemm(const Params& P, char* shm) {
  const u16* pooled = (const u16*)(P.ws + OFF_POOLED);
  const u16* W = (const u16*)(P.ws + OFF_W) + W_POOL;
  u16* actB = (u16*)(P.ws + OFF_ACTB);
  const int tid = tid_(), lane = tid & 63, wid = tid >> 6, wr = wid >> 2, wc = wid & 3, fr = lane & 15, fq = lane >> 4;
  for (int tl = blockIdx.x; tl < 128 * 2; tl += gridDim.x) {
    int pm, pn;
    tile_map(tl, 128, 2, pm, pn);
    const int brow = pm * 256, bcol = pn * 256;
    f32x4 acc[8][4];
    gemm_main<8, 4>(acc, pooled + (size_t)brow * 512, 512, W + (size_t)bcol * 512, 512, 512, shm);
#pragma unroll
    for (int m = 0; m < 8; ++m)
#pragma unroll
      for (int n = 0; n < 4; ++n) {
        const int row = wr * 128 + m * 16 + fr, col = wc * 64 + n * 16 + fq * 4;
        u32x2 o = {pack2(acc[m][n][0], acc[m][n][1]), pack2(acc[m][n][2], acc[m][n][3])};
        *(u32x2*)(shm + row * 528 + col * 2) = o;
      }
    __syncthreads();
#pragma unroll 4
    for (int i = 0; i < 16; ++i) {
      const int chunk = tid_() + i * 512, row = chunk >> 5, c8 = (chunk & 31) * 8;
      const i32x4 v = *(const i32x4*)(shm + row * 528 + c8 * 2);
      u16* d = actB + (size_t)(brow + row) * 512 + bcol + c8;
      const i32x4 g = *(const i32x4*)d;
      i32x4 o;
#pragma unroll
      for (int e = 0; e < 4; ++e)
        o[e] = (int)pack2(bflo((unsigned)v[e]) * bflo((unsigned)g[e]), bfhi((unsigned)v[e]) * bfhi((unsigned)g[e]));
      *(i32x4*)d = o;
    }
    __syncthreads();
  }
}

DI void phase_outproj(const Params& P, char* shm) {
  constexpr int TILE_A = 32768, STAGE = 49152, NS = 96;
  const u16* hb = (const u16*)(P.ws + OFF_HB);
  const u16* W = (const u16*)(P.ws + OFF_W);
  u16* merged = (u16*)(P.ws + OFF_MERGED);
  const int tid = tid_(), lane = tid & 63, wid = tid >> 6, wr = wid >> 2, wc = wid & 3, fr = lane & 15, fq = lane >> 4;
  int sR0, sC0;
  stage_rc<2>(wid * 1024 + lane * 16, sR0, sC0);
  const int p1024 = sR0 * 1024 + sC0, p512 = sR0 * 512 + sC0;
  const int a_off = lds_byte<2>(fr, fq * 8) + wr * (8 * 2048);
  const int b_off = lds_byte<2>(fr, fq * 8) + wc * (2 * 2048);
  for (int tl = blockIdx.x; tl < 128 * 8; tl += gridDim.x) {
    int pm, pn;
    tile_map(tl, 128, 8, pm, pn);
    const int brow = pm * 256, bcol = pn * 128;
    f32x4 sum[8][2], acc[8][2];
    unsigned gp[8][2][2];
#pragma unroll
    for (int m = 0; m < 8; ++m)
#pragma unroll
      for (int n = 0; n < 2; ++n) {
        sum[m][n] = f32x4{0.f, 0.f, 0.f, 0.f};
      }
#define O_ISSUE(xs, rs_, buf)                                                                              \
  do {                                                                                                     \
    const bool gate_ = (rs_) < 16;                                                                         \
    const u16* Ab_ = gate_ ? hb + (size_t)brow * DM                                                        \
                           : (const u16*)(P.ws + OFF_ACTA + (size_t)(xs) * 32 * MiB) + (size_t)brow * 512; \
    const u16* Bb_ = gate_ ? W + W_IN + (size_t)(WR_GATE + (xs) * 1024 + bcol) * DM                        \
                           : W + W_A + (size_t)(xs) * 524288 + (size_t)bcol * 512;                         \
    const int ld_ = gate_ ? 1024 : 512, p0_ = gate_ ? p1024 : p512, kt_ = gate_ ? (rs_) : (rs_) - 16;      \
    _Pragma("unroll") for (int i = 0; i < 4; ++i) __builtin_amdgcn_global_load_lds(                        \
        (const unsigned*)(Ab_ + (p0_ + i * 64 * ld_ + kt_ * 64)),                                          \
        (unsigned*)(shm + (buf) * STAGE + wid * 1024 + i * 8192), 16, 0, 0);                               \
    _Pragma("unroll") for (int i = 0; i < 2; ++i) __builtin_amdgcn_global_load_lds(                        \
        (const unsigned*)(Bb_ + (p0_ + i * 64 * ld_ + kt_ * 64)),                                          \
        (unsigned*)(shm + (buf) * STAGE + TILE_A + wid * 1024 + i * 8192), 16, 0, 0);                      \
  } while (0)
    O_ISSUE(0, 0, 0);
    O_ISSUE(0, 1, 1);
    asm volatile("s_waitcnt vmcnt(6)" ::: "memory");
    asm volatile("s_waitcnt lgkmcnt(0)" ::: "memory");
    __builtin_amdgcn_s_barrier();
    int cur = 0, nxt = 2;
#define O_COMPUTE()                                                                                        \
  do {                                                                                                     \
    const char* sA = shm + cur * STAGE;                                                                    \
    const char* sB = sA + TILE_A;                                                                          \
    _Pragma("unroll") for (int ks = 0; ks < 2; ++ks) {                                                     \
      bf16x8 Bf[2];                                                                                        \
      _Pragma("unroll") for (int n = 0; n < 2; ++n) Bf[n] = *(const bf16x8*)(sB + b_off + n * 2048 + ks * 1024); \
      _Pragma("unroll") for (int mg = 0; mg < 2; ++mg) {                                                   \
        bf16x8 At[4];                                                                                      \
        _Pragma("unroll") for (int m = 0; m < 4; ++m)                                                      \
            At[m] = *(const bf16x8*)(sA + a_off + (mg * 4 + m) * 2048 + ks * 1024);                        \
        _Pragma("unroll") for (int m = 0; m < 4; ++m) _Pragma("unroll") for (int n = 0; n < 2; ++n)        \
            acc[mg * 4 + m][n] = MFMA16(Bf[n], At[m], acc[mg * 4 + m][n]);                                 \
        if (mg == 0) __builtin_amdgcn_sched_group_barrier(0x100, 6, 0);                                    \
        else __builtin_amdgcn_sched_group_barrier(0x100, 4, 0);                                            \
        __builtin_amdgcn_sched_group_barrier(0x008, 8, 0);                                                 \
        __builtin_amdgcn_sched_barrier(0);                                                                 \
      }                                                                                                    \
    }                                                                                                      \
  } while (0)
#define O_ROTATE()                                                                                         \
  do {                                                                                                     \
    asm volatile("s_waitcnt lgkmcnt(0)" ::: "memory");                                                     \
    __builtin_amdgcn_s_barrier();                                                                          \
    cur = (cur == 2) ? 0 : cur + 1;                                                                        \
    nxt = (nxt == 2) ? 0 : nxt + 1;                                                                        \
  } while (0)
#pragma clang loop unroll(disable)
    for (int x = 0; x < 4; ++x) {
#pragma unroll
      for (int m = 0; m < 8; ++m) { acc[m][0] = f32x4{0.f, 0.f, 0.f, 0.f}; acc[m][1] = f32x4{0.f, 0.f, 0.f, 0.f}; }
#pragma clang loop unroll(disable)
      for (int r = 0; r < 16; ++r) {
        O_ISSUE(x, r + 2, nxt);
        O_COMPUTE();
        asm volatile("s_waitcnt vmcnt(6)" ::: "memory");
        O_ROTATE();
      }
#pragma unroll
      for (int m = 0; m < 8; ++m)
#pragma unroll
        for (int n = 0; n < 2; ++n) {
          gp[m][n][0] = pack2(sigmoidf_(acc[m][n][0]), sigmoidf_(acc[m][n][1]));
          gp[m][n][1] = pack2(sigmoidf_(acc[m][n][2]), sigmoidf_(acc[m][n][3]));
          acc[m][n] = f32x4{0.f, 0.f, 0.f, 0.f};
        }
#pragma clang loop unroll(disable)
      for (int q = 0; q < 8; ++q) {
        const bool more = (q < 6) || (x < 3);
        if (q < 6) O_ISSUE(x, 18 + q, nxt);
        else if (x < 3) O_ISSUE(x + 1, q - 6, nxt);
        O_COMPUTE();
        if (more) asm volatile("s_waitcnt vmcnt(6)" ::: "memory");
        else asm volatile("s_waitcnt vmcnt(0)" ::: "memory");
        O_ROTATE();
      }
#pragma unroll
      for (int m = 0; m < 8; ++m)
#pragma unroll
        for (int n = 0; n < 2; ++n) {
          sum[m][n][0] += bflo(gp[m][n][0]) * acc[m][n][0];
          sum[m][n][1] += bfhi(gp[m][n][0]) * acc[m][n][1];
          sum[m][n][2] += bflo(gp[m][n][1]) * acc[m][n][2];
          sum[m][n][3] += bfhi(gp[m][n][1]) * acc[m][n][3];
        }
    }
#undef O_COMPUTE
#undef O_ROTATE
#undef O_ISSUE
#pragma unroll
    for (int m = 0; m < 8; ++m)
#pragma unroll
      for (int n = 0; n < 2; ++n) {
        const int row = wr * 128 + m * 16 + fr, col = wc * 32 + n * 16 + fq * 4;
        u32x2 o = {pack2(sum[m][n][0], sum[m][n][1]), pack2(sum[m][n][2], sum[m][n][3])};
        *(u32x2*)(shm + row * 272 + col * 2) = o;
      }
    __syncthreads();
#pragma unroll
    for (int i = 0; i < 8; ++i) {
      const int chunk = tid_() + i * 512, row = chunk >> 4, c8 = (chunk & 15) * 8;
      const i32x4 v = *(const i32x4*)(shm + row * 272 + c8 * 2);
      *(i32x4*)(merged + (size_t)(brow + row) * DM + bcol + c8) = v;
    }
    __syncthreads();
  }
}

DI void phase_wo(const Params& P, const float* xin, char* shm) {
  const u16* merged = (const u16*)(P.ws + OFF_MERGED);
  const u16* W = (const u16*)(P.ws + OFF_W) + W_O;
  const int tid = tid_(), lane = tid & 63, wid = tid >> 6, wr = wid >> 2, wc = wid & 3, fr = lane & 15, fq = lane >> 4;
  for (int tl = blockIdx.x; tl < 128 * 4; tl += gridDim.x) {
    int pm, pn;
    tile_map(tl, 128, 4, pm, pn);
    const int brow = pm * 256, bcol = pn * 256;
    f32x4 acc[8][4];
    gemm_main<8, 4>(acc, merged + (size_t)brow * DM, DM, W + (size_t)bcol * DM, DM, DM, shm);
#pragma unroll
    for (int ps = 0; ps < 2; ++ps) {
      if (wr == ps) {
#pragma unroll
        for (int m = 0; m < 8; ++m)
#pragma unroll
          for (int n = 0; n < 4; ++n) {
            const int row = m * 16 + fr, col = wc * 64 + n * 16 + fq * 4;
            *(f32x4*)(shm + row * 1040 + col * 4) = acc[m][n];
          }
      }
      __syncthreads();
#pragma unroll 4
      for (int i = 0; i < 16; ++i) {
        const int chunk = tid_() + i * 512, row = chunk >> 6, c4 = (chunk & 63) * 4;
        const f32x4 v = *(const f32x4*)(shm + row * 1040 + c4 * 4);
        const size_t off = (size_t)(brow + ps * 128 + row) * DM + bcol + c4;
        const f32x4 xv = *(const f32x4*)(xin + off);
        *(f32x4*)(P.out + off) = xv + v;
      }
      __syncthreads();
    }
  }
}

DI void phase_ple(const Params& P, char* shm) {
  const u16* hb = (const u16*)(P.ws + OFF_HB);
  const u16* pb = (const u16*)(P.ws + OFF_PB);
  const u16* W = (const u16*)(P.ws + OFF_W);
  const int tid = tid_(), lane = tid & 63, wid = tid >> 6, wr = wid >> 2, wc = wid & 3, fr = lane & 15, fq = lane >> 4;
  for (int tl = blockIdx.x; tl < 128 * 8; tl += gridDim.x) {
    int pm, pn;
    tile_map(tl, 128, 8, pm, pn);
    const int brow = pm * 256, bcol = pn * 128;
    f32x4 e[8][2], acc[8][2];
    {
      constexpr int TILE_A = 32768, STAGE = 49152;
      int sR0, sC0;
      stage_rc<2>(wid * 1024 + lane * 16, sR0, sC0);
      const int p1024 = sR0 * 1024 + sC0, p256 = sR0 * 256 + sC0;
      const int a_off = lds_byte<2>(fr, fq * 8) + wr * (8 * 2048);
      const int b_off = lds_byte<2>(fr, fq * 8) + wc * (2 * 2048);
#define P_ISSUE(rs_, buf)                                                                                  \
  do {                                                                                                     \
    const bool e_ = (rs_) < 4;                                                                             \
    const u16* Ab_ = e_ ? pb + (size_t)brow * 256 : hb + (size_t)brow * DM;                                \
    const u16* Bb_ = e_ ? W + W_PLE + (size_t)bcol * 256 : W + W_G + (size_t)bcol * DM;                    \
    const int ld_ = e_ ? 256 : 1024, p0_ = e_ ? p256 : p1024, kt_ = e_ ? (rs_) : (rs_) - 4;                \
    _Pragma("unroll") for (int i = 0; i < 4; ++i) __builtin_amdgcn_global_load_lds(                        \
        (const unsigned*)(Ab_ + (p0_ + i * 64 * ld_ + kt_ * 64)),                                          \
        (unsigned*)(shm + (buf) * STAGE + wid * 1024 + i * 8192), 16, 0, 0);                               \
    _Pragma("unroll") for (int i = 0; i < 2; ++i) __builtin_amdgcn_global_load_lds(                        \
        (const unsigned*)(Bb_ + (p0_ + i * 64 * ld_ + kt_ * 64)),                                          \
        (unsigned*)(shm + (buf) * STAGE + TILE_A + wid * 1024 + i * 8192), 16, 0, 0);                      \
  } while (0)
#define P_COMPUTE()                                                                                        \
  do {                                                                                                     \
    const char* sA = shm + cur * STAGE;                                                                    \
    const char* sB = sA + TILE_A;                                                                          \
    _Pragma("unroll") for (int ks = 0; ks < 2; ++ks) {                                                     \
      bf16x8 Bf[2];                                                                                        \
      _Pragma("unroll") for (int n = 0; n < 2; ++n) Bf[n] = *(const bf16x8*)(sB + b_off + n * 2048 + ks * 1024); \
      _Pragma("unroll") for (int mg = 0; mg < 2; ++mg) {                                                   \
        bf16x8 At[4];                                                                                      \
        _Pragma("unroll") for (int m = 0; m < 4; ++m)                                                      \
            At[m] = *(const bf16x8*)(sA + a_off + (mg * 4 + m) * 2048 + ks * 1024);                        \
        _Pragma("unroll") for (int m = 0; m < 4; ++m) _Pragma("unroll") for (int n = 0; n < 2; ++n)        \
            acc[mg * 4 + m][n] = MFMA16(Bf[n], At[m], acc[mg * 4 + m][n]);                                 \
        if (mg == 0) __builtin_amdgcn_sched_group_barrier(0x100, 6, 0);                                    \
        else __builtin_amdgcn_sched_group_barrier(0x100, 4, 0);                                            \
        __builtin_amdgcn_sched_group_barrier(0x008, 8, 0);                                                 \
        __builtin_amdgcn_sched_barrier(0);                                                                 \
      }                                                                                                    \
    }                                                                                                      \
  } while (0)
#define P_ROTATE()                                                                                         \
  do {                                                                                                     \
    asm volatile("s_waitcnt lgkmcnt(0)" ::: "memory");                                                     \
    __builtin_amdgcn_s_barrier();                                                                          \
    cur = (cur == 2) ? 0 : cur + 1;                                                                        \
    nxt = (nxt == 2) ? 0 : nxt + 1;                                                                        \
  } while (0)
      P_ISSUE(0, 0);
      P_ISSUE(1, 1);
      asm volatile("s_waitcnt vmcnt(6)" ::: "memory");
      asm volatile("s_waitcnt lgkmcnt(0)" ::: "memory");
      __builtin_amdgcn_s_barrier();
      int cur = 0, nxt = 2;
#pragma unroll
      for (int m = 0; m < 8; ++m) { acc[m][0] = f32x4{0.f, 0.f, 0.f, 0.f}; acc[m][1] = f32x4{0.f, 0.f, 0.f, 0.f}; }
#pragma clang loop unroll(disable)
      for (int r = 0; r < 4; ++r) {
        P_ISSUE(r + 2, nxt);
        P_COMPUTE();
        asm volatile("s_waitcnt vmcnt(6)" ::: "memory");
        P_ROTATE();
      }
#pragma unroll
      for (int m = 0; m < 8; ++m)
#pragma unroll
        for (int n = 0; n < 2; ++n) { e[m][n] = acc[m][n]; acc[m][n] = f32x4{0.f, 0.f, 0.f, 0.f}; }
#pragma clang loop unroll(disable)
      for (int q = 0; q < 16; ++q) {
        if (q < 14) P_ISSUE(q + 6, nxt);
        P_COMPUTE();
        if (q < 14) asm volatile("s_waitcnt vmcnt(6)" ::: "memory");
        else asm volatile("s_waitcnt vmcnt(0)" ::: "memory");
        P_ROTATE();
      }
#undef P_ISSUE
#undef P_COMPUTE
#undef P_ROTATE
    }
#pragma unroll
    for (int m = 0; m < 8; ++m)
#pragma unroll
      for (int n = 0; n < 2; ++n) {
        const int row = wr * 128 + m * 16 + fr, col = wc * 32 + n * 16 + fq * 4;
        f32x4 v;
#pragma unroll
        for (int j = 0; j < 4; ++j) v[j] = sigmoidf_(acc[m][n][j]) * e[m][n][j];
        *(f32x4*)(shm + row * 528 + col * 4) = v;
      }
    __syncthreads();
#pragma unroll 4
    for (int i = 0; i < 16; ++i) {
      const int chunk = tid_() + i * 512, row = chunk >> 5, c4 = (chunk & 31) * 4;
      const f32x4 v = *(const f32x4*)(shm + row * 528 + c4 * 4);
      float* d = P.out + (size_t)(brow + row) * DM + bcol + c4;
      *(f32x4*)d = *(const f32x4*)d + v;
    }
    __syncthreads();
  }
}

DI void gbar(char* ws, int idx) {
  unsigned* cnt = (unsigned*)(ws + OFF_BAR) + idx * 64;
  asm volatile("s_waitcnt vmcnt(0)" ::: "memory");
  __syncthreads();
  if (threadIdx.x == 0) {
    __builtin_amdgcn_fence(__ATOMIC_RELEASE, "agent");
    asm volatile("s_waitcnt vmcnt(0)" ::: "memory");
    __hip_atomic_fetch_add(cnt, 1u, __ATOMIC_RELAXED, __HIP_MEMORY_SCOPE_AGENT);
    while (__hip_atomic_load(cnt, __ATOMIC_RELAXED, __HIP_MEMORY_SCOPE_AGENT) < gridDim.x) __builtin_amdgcn_s_sleep(1);
    __builtin_amdgcn_fence(__ATOMIC_ACQUIRE, "agent");
    asm volatile("s_waitcnt vmcnt(0)" ::: "memory");
  }
  __syncthreads();
}
DI unsigned xb_ld(unsigned* p) { return __hip_atomic_load(p, __ATOMIC_RELAXED, __HIP_MEMORY_SCOPE_AGENT); }
DI unsigned xb_add(unsigned* p, unsigned v) { return __hip_atomic_fetch_add(p, v, __ATOMIC_RELAXED, __HIP_MEMORY_SCOPE_AGENT); }
DI void xbar(char* ws, unsigned gen, unsigned xcc, unsigned nloc, unsigned nx) {
  unsigned* bar = (unsigned*)(ws + OFF_BAR);
  asm volatile("s_waitcnt vmcnt(0)" ::: "memory");
  __syncthreads();
  if (threadIdx.x == 0) {
    const unsigned old = xb_add(&bar[5120 + 64 * xcc], 1u);
    if (old == gen * nloc - 1u) {
      __builtin_amdgcn_fence(__ATOMIC_RELEASE, "agent");
      asm volatile("s_waitcnt vmcnt(0)" ::: "memory");
      const unsigned t = xb_add(&bar[7168], 1u);
      if (t == gen * nx - 1u) __hip_atomic_store(&bar[7232], gen, __ATOMIC_RELAXED, __HIP_MEMORY_SCOPE_AGENT);
      else while (xb_ld(&bar[7232]) < gen) __builtin_amdgcn_s_sleep(1);
      __hip_atomic_store(&bar[6144 + 64 * xcc], gen, __ATOMIC_RELAXED, __HIP_MEMORY_SCOPE_AGENT);
    } else {
      while (xb_ld(&bar[6144 + 64 * xcc]) < gen) __builtin_amdgcn_s_sleep(1);
    }
    __builtin_amdgcn_fence(__ATOMIC_ACQUIRE, "agent");
    asm volatile("s_waitcnt vmcnt(0)" ::: "memory");
  }
  __syncthreads();
}

#ifndef PROBE
#define PROBE 0
#endif
#define PH(...)                                                     \
  {                                                                 \
    Params Q = P;                                                   \
    asm volatile("" : "+s"(Q.ws), "+s"(Q.out), "+s"(Q.x));        \
    __VA_ARGS__;                                                    \
  }
__global__ void __launch_bounds__(512) fwd_megakernel(Params P) {
  __shared__ __attribute__((aligned(1024))) char shm[148480];
  cg::grid_group grid = cg::this_grid();
  const unsigned xcc = (unsigned)__builtin_amdgcn_s_getreg((3 << 11) | 20) & 0xFu;
  if (threadIdx.x == 0) xb_add((unsigned*)(P.ws + OFF_BAR) + 4096 + 64 * xcc, 1u);
  gbar(P.ws, 63);
  unsigned nloc = 0, nx = 0, bgen = 0;
  {
    unsigned* bar = (unsigned*)(P.ws + OFF_BAR);
    nloc = xb_ld(&bar[4096 + 64 * xcc]);
#pragma unroll
    for (int j = 0; j < 16; ++j) nx += (xb_ld(&bar[4096 + 64 * j]) != 0u) ? 1u : 0u;
  }
#define GSYNC(k) xbar(P.ws, ++bgen, xcc, nloc, nx)
  if (P.ws == nullptr) grid.sync();
#pragma clang loop unroll(disable)
  for (int l = 0; l < 2; ++l) {
#if PROBE == 7
    PH(phase_prep(Q, l, shm));
    PH(phase_rope(Q));
    PH(phase_norm(l == 0 ? Q.x : Q.out, (u16*)(Q.ws + OFF_HB)));
    GSYNC(0);
#endif
#if PROBE == 10
    for (int r = 0; r < 10; ++r) GSYNC(1);
#endif
    PH(phase_prep(Q, l, shm));
    if (l == 0) PH(phase_rope(Q));
    PH(phase_norm(l == 0 ? Q.x : Q.out, (u16*)(Q.ws + OFF_HB)));
    GSYNC(2);
#if PROBE == 3
    PH(phase_inproj<0>(Q, shm));
    PH(phase_inproj<1>(Q, shm));
    GSYNC(3);
#endif
    PH(phase_inproj<0>(Q, shm));
    PH(phase_inproj<1>(Q, shm));
    GSYNC(4);
    PH(phase_attn_d(Q, shm));
    PH(phase_mla_up(Q, l, shm));
    GSYNC(5);
#if PROBE == 8
    { int dry = 1; asm volatile("" : "+s"(dry)); PH(phase_kprep(Q, l, dry)); GSYNC(6); }
#endif
#if PROBE == 11
    { int dry = 1; asm volatile("" : "+s"(dry)); PH(phase_attn_d(Q, shm, dry)); GSYNC(7); }
#endif
#if PROBE == 1
    { int dry = 1; asm volatile("" : "+s"(dry)); PH(phase_attn_c(Q, l, shm, dry)); GSYNC(9); }
#endif
    PH(phase_attn_c(Q, l, shm, 0));
#if PROBE == 3
    PH(phase_inproj<2>(Q, shm));
    PH(phase_inproj<3>(Q, shm));
    GSYNC(11);
#endif
    PH(phase_inproj<2>(Q, shm));
    PH(phase_inproj<3>(Q, shm));
    GSYNC(12);
#if PROBE == 9
    { int dry = 1; asm volatile("" : "+s"(dry)); PH(phase_sgu(Q, l, shm, dry)); GSYNC(13); }
#endif
#if PROBE == 12
    PH(phase_pooled(Q)); GSYNC(14);
#endif
    PH(phase_sgu(Q, l, shm));
    PH(phase_pooled(Q));
    GSYNC(15);
    PH(phase_pool_gemm(Q, shm));
    GSYNC(16);
#if PROBE == 2
    PH(phase_outproj(Q, shm));
    GSYNC(17);
#endif
    PH(phase_outproj(Q, shm));
    GSYNC(18);
    PH(phase_wo(Q, l == 0 ? Q.x : Q.out, shm));
    GSYNC(19);
    PH(phase_norm(Q.out, (u16*)(Q.ws + OFF_HB)));
    GSYNC(20);
    PH(phase_ple(Q, shm));
    GSYNC(21);
  }
}

extern "C" void kernel_launch(void* const* d_in, const int* in_sizes, int n_in, void* d_out, int out_size,
                              void* d_ws, size_t ws_size, hipStream_t stream) {
  static int grid_blocks = 0;
  if (!grid_blocks) {
    int dev = 0, cus = 0, per_cu = 0;
    hipGetDevice(&dev);
    hipDeviceGetAttribute(&cus, hipDeviceAttributeMultiprocessorCount, dev);
    hipOccupancyMaxActiveBlocksPerMultiprocessor(&per_cu, fwd_megakernel, 512, 0);
    if (per_cu < 1) per_cu = 1;
    grid_blocks = cus * per_cu;
    if (grid_blocks > 256) grid_blocks = 256;
    grid_blocks &= ~7;
  }
  Params P{};
  P.x = (const float*)d_in[0]; P.p = (const float*)d_in[1]; P.pos = (const int*)d_in[2];
  P.norm_g = (const float*)d_in[3]; P.w_in = (const float*)d_in[4]; P.ln_v_g = (const float*)d_in[5];
  P.ln_v_b = (const float*)d_in[6]; P.sgu_w = (const float*)d_in[7]; P.sgu_b = (const float*)d_in[8];
  P.w_a_out = (const float*)d_in[9]; P.pool_w = (const float*)d_in[10]; P.pool_scale = (const float*)d_in[11];
  P.w_b_out = (const float*)d_in[12]; P.cq_norm_g = (const float*)d_in[13]; P.w_uq = (const float*)d_in[14];
  P.ckv_norm_g = (const float*)d_in[15]; P.w_ukv = (const float*)d_in[16]; P.q_norm_g = (const float*)d_in[17];
  P.k_norm_g = (const float*)d_in[18]; P.w_c_out = (const float*)d_in[19]; P.w_d_out = (const float*)d_in[20];
  P.w_o = (const float*)d_in[21]; P.w_ple = (const float*)d_in[22]; P.ple_norm_g = (const float*)d_in[23];
  P.w_ple_gate = (const float*)d_in[24];
  P.out = (float*)d_out; P.ws = (char*)d_ws;
  hipMemsetAsync((char*)d_ws + OFF_BAR, 0, 32768, stream);
  void* args[] = {&P};
  hipError_t e = hipLaunchCooperativeKernel((void*)fwd_megakernel, dim3(grid_blocks), dim3(512), args, 0, stream);
  if (e != hipSuccess) fprintf(stderr, "cooperative launch failed: %s (grid %d)\n", hipGetErrorString(e), grid_blocks);
}
```

```cpp
#include <hip/hip_runtime.h>
#include <hip/hip_cooperative_groups.h>
#include <cstdio>
namespace cg = cooperative_groups;

typedef unsigned short u16;
using bf16x8 = __attribute__((ext_vector_type(8))) short;
using f32x4 = __attribute__((ext_vector_type(4))) float;
using i32x4 = __attribute__((ext_vector_type(4))) int;
using u32x2 = __attribute__((ext_vector_type(2))) unsigned;
typedef __bf16 bf16x2_t __attribute__((ext_vector_type(2)));
typedef float f32x2_t __attribute__((ext_vector_type(2)));
#define DI __device__ __forceinline__
#define CBAR() asm volatile("" ::: "memory")
#define MFMA16(a, b, c) __builtin_amdgcn_mfma_f32_16x16x32_bf16((a), (b), (c), 0, 0, 0)

constexpr int T_TOK = 32768, SEQ = 8192, DM = 1024;
constexpr float EPS = 1e-6f;
constexpr size_t MiB = 1u << 20;
constexpr size_t OFF_W = 0, OFF_PB = 32 * MiB, OFF_HB = 48 * MiB, OFF_ACTA = 112 * MiB, OFF_ACTB = 144 * MiB,
                 OFF_ACTC = 176 * MiB, OFF_ACTD = 208 * MiB, OFF_PROJC = 240 * MiB, OFF_QRAW = 272 * MiB,
                 OFF_KC = 320 * MiB, OFF_VTC = 368 * MiB, OFF_PROJD = 400 * MiB, OFF_VTD = 464 * MiB,
                 OFF_ROPE = 496 * MiB, OFF_BAR = 504 * MiB, OFF_PROJA = 400 * MiB, OFF_PROJB = 464 * MiB, OFF_POOLED = 240 * MiB, OFF_MERGED = 272 * MiB;
constexpr size_t W_IN = 0, W_A = 9961472, W_B = W_A + 524288, W_C = W_B + 524288, W_D = W_C + 524288,
                 W_O = W_D + 524288, W_PLE = W_O + 1048576, W_G = W_PLE + 262144, W_UQ = W_G + 1048576,
                 W_UKV = W_UQ + 196608, W_POOL = W_UKV + 131072, W_SGU = W_POOL + 262144;
constexpr int WR_A = 0, WR_B = 1536, WR_C = 2560, WR_D = 3584, WR_GATE = 5632;

struct Params {
  const float* x; const float* p; const int* pos;
  const float *norm_g, *w_in, *ln_v_g, *ln_v_b, *sgu_w, *sgu_b, *w_a_out, *pool_w, *pool_scale, *w_b_out,
      *cq_norm_g, *w_uq, *ckv_norm_g, *w_ukv, *q_norm_g, *k_norm_g, *w_c_out, *w_d_out, *w_o, *w_ple,
      *ple_norm_g, *w_ple_gate;
  float* out; char* ws;
};

DI unsigned pack2(float a, float b) {
  f32x2_t v = {a, b};
  bf16x2_t r = __builtin_convertvector(v, bf16x2_t);
  return __builtin_bit_cast(unsigned, r);
}
DI u16 f2bf(float a) { return (u16)(pack2(a, 0.f) & 0xffffu); }
DI float bf2f(u16 v) { return __uint_as_float(((unsigned)v) << 16); }
DI float bflo(unsigned v) { return __uint_as_float(v << 16); }
DI float bfhi(unsigned v) { return __uint_as_float(v & 0xffff0000u); }
DI float sigmoidf_(float x) { return __builtin_amdgcn_rcpf(1.f + __expf(-x)); }
DI float siluf_(float x) { return x * __builtin_amdgcn_rcpf(1.f + __expf(-x)); }

template <int KS> DI int lds_byte(int r, int c) {
  int st = (r >> 4) * KS + (c >> 5), ob = (r & 15) * 64 + (c & 31) * 2;
  return st * 1024 + (ob ^ (((ob >> 9) & 1) << 5));
}
template <int KS> DI void stage_rc(int b, int& R, int& C) {
  int st = b >> 10, sb = b & 1023, swz = sb ^ (((sb >> 9) & 1) << 5);
  R = (st / KS) * 16 + swz / 64;
  C = (st % KS) * 32 + (swz % 64) / 2;
}

DI int tid_() { int t = threadIdx.x; asm volatile("" : "+v"(t)); return t; }
DI void tile_map(int wgid, int nM, int nN, int& pm, int& pn) {
  const int nwg = nM * nN, q = nwg / 8, r = nwg % 8, xcd = wgid % 8, off = wgid / 8;
  int w2 = (xcd < r ? xcd * (q + 1) : r * (q + 1) + (xcd - r) * q) + off;
  const int WGM = 8;
  int nig = WGM * nN, gid = w2 / nig, fm = gid * WGM, gsz = min(nM - fm, WGM);
  pm = fm + ((w2 % nig) % gsz);
  pn = (w2 % nig) / gsz;
}

template <int MF, int NF, bool SWAP = true>
DI void gemm_main(f32x4 (&acc)[MF][NF], const u16* __restrict__ Ab, int lda, const u16* __restrict__ Bb, int ldb,
                  int K, char* shm) {
  constexpr bool RING3 = (NF == 2);
  constexpr int TILE_A = 32768, STAGE = RING3 ? 49152 : 65536;
  const int tid = tid_(), wid = tid >> 6, lane = tid & 63, wr = wid >> 2, wc = wid & 3, fr = lane & 15,
            fq = lane >> 4;
  constexpr int AL = MF / 2;
  int sR0, sC0;
  stage_rc<2>(wid * 1024 + lane * 16, sR0, sC0);
#pragma unroll
  for (int m = 0; m < MF; ++m)
#pragma unroll
    for (int n = 0; n < NF; ++n) acc[m][n] = f32x4{0.f, 0.f, 0.f, 0.f};
  const int nt = K >> 6;
  const int pa0 = sR0 * lda + sC0, pb0 = sR0 * ldb + sC0;
#define G_STAGE(buf, kt)                                                                                \
  do {                                                                                                  \
    _Pragma("unroll") for (int i = 0; i < AL; ++i) __builtin_amdgcn_global_load_lds(                    \
        (const unsigned*)(Ab + (pa0 + i * 64 * lda + (kt) * 64)), (unsigned*)(shm + (buf) * STAGE + wid * 1024 + i * 8192), 16, 0, 0); \
    _Pragma("unroll") for (int i = 0; i < NF; ++i) __builtin_amdgcn_global_load_lds(                    \
        (const unsigned*)(Bb + (pb0 + i * 64 * ldb + (kt) * 64)), (unsigned*)(shm + (buf) * STAGE + TILE_A + wid * 1024 + i * 8192), 16, 0, 0); \
  } while (0)
  const int a_off = lds_byte<2>(fr, fq * 8) + wr * (MF * 2048);
  const int b_off = lds_byte<2>(fr, fq * 8) + wc * (NF * 2048);
  G_STAGE(0, 0);
  if constexpr (RING3) {
    if (nt > 1) { G_STAGE(1, 1); asm volatile("s_waitcnt vmcnt(6)" ::: "memory"); }
    else asm volatile("s_waitcnt vmcnt(0)" ::: "memory");
    asm volatile("s_waitcnt lgkmcnt(0)" ::: "memory");
    __builtin_amdgcn_s_barrier();
  } else {
    asm volatile("s_waitcnt vmcnt(0)" ::: "memory");
    __syncthreads();
  }
  int cur3 = 0, nxt3 = 2;
#pragma clang loop unroll(disable)
  for (int t = 0; t < nt; ++t) {
    const int cur = RING3 ? cur3 : (t & 1);
    if constexpr (RING3) {
      if (t + 2 < nt) G_STAGE(nxt3, t + 2);
    } else {
      if (t + 1 < nt) G_STAGE(cur ^ 1, t + 1);
    }
    const char* sA = shm + cur * STAGE;
    const char* sB = sA + TILE_A;
    if constexpr (MF == 8 && NF == 4) {
      bf16x8 B0[4], B1[4], A0[4], A1[4], A2[4], A3[4];
#define LDB_(dst, ks) _Pragma("unroll") for (int n = 0; n < 4; ++n) dst[n] = *(const bf16x8*)(sB + b_off + n * 2048 + (ks) * 1024)
#define LDA_(dst, ks, h) _Pragma("unroll") for (int m = 0; m < 4; ++m) dst[m] = *(const bf16x8*)(sA + a_off + ((h) * 4 + m) * 2048 + (ks) * 1024)
#define MMA_(A, B, h) _Pragma("unroll") for (int m = 0; m < 4; ++m) _Pragma("unroll") for (int n = 0; n < 4; ++n) \
      acc[(h) * 4 + m][n] = SWAP ? MFMA16(B[n], A[m], acc[(h) * 4 + m][n]) : MFMA16(A[m], B[n], acc[(h) * 4 + m][n])
      LDB_(B0, 0); LDA_(A0, 0, 0);
      LDA_(A1, 0, 1); MMA_(A0, B0, 0);
      LDB_(B1, 1); LDA_(A2, 1, 0); MMA_(A1, B0, 1);
      LDA_(A3, 1, 1); MMA_(A2, B1, 0);
      MMA_(A3, B1, 1);
#undef LDB_
#undef LDA_
#undef MMA_
      __builtin_amdgcn_sched_group_barrier(0x100, 8, 0);
#pragma unroll
      for (int i = 0; i < 4; ++i) { __builtin_amdgcn_sched_group_barrier(0x100, 1, 0); __builtin_amdgcn_sched_group_barrier(0x008, 4, 0); }
#pragma unroll
      for (int i = 0; i < 8; ++i) { __builtin_amdgcn_sched_group_barrier(0x100, 1, 0); __builtin_amdgcn_sched_group_barrier(0x008, 2, 0); }
#pragma unroll
      for (int i = 0; i < 4; ++i) { __builtin_amdgcn_sched_group_barrier(0x100, 1, 0); __builtin_amdgcn_sched_group_barrier(0x008, 4, 0); }
      __builtin_amdgcn_sched_group_barrier(0x008, 16, 0);
      __builtin_amdgcn_sched_barrier(0);
    } else {
#pragma unroll
    for (int ks = 0; ks < 2; ++ks) {
      bf16x8 Bf[NF];
#pragma unroll
      for (int n = 0; n < NF; ++n) Bf[n] = *(const bf16x8*)(sB + b_off + n * 2048 + ks * 1024);
      constexpr int MG = (NF == 2 && MF == 8) ? 4 : MF;
#pragma unroll
      for (int mg = 0; mg < MF / MG; ++mg) {
        bf16x8 At[MG];
#pragma unroll
        for (int m = 0; m < MG; ++m) At[m] = *(const bf16x8*)(sA + a_off + (mg * MG + m) * 2048 + ks * 1024);
#pragma unroll
        for (int m = 0; m < MG; ++m)
#pragma unroll
          for (int n = 0; n < NF; ++n)
            acc[mg * MG + m][n] = SWAP ? MFMA16(Bf[n], At[m], acc[mg * MG + m][n]) : MFMA16(At[m], Bf[n], acc[mg * MG + m][n]);
        if (mg == 0) __builtin_amdgcn_sched_group_barrier(0x100, MG + NF, 0);
        else __builtin_amdgcn_sched_group_barrier(0x100, MG, 0);
        __builtin_amdgcn_sched_group_barrier(0x008, MG * NF, 0);
        __builtin_amdgcn_sched_barrier(0);
      }
    }
    }
    if constexpr (RING3) {
      if (t + 2 < nt) asm volatile("s_waitcnt vmcnt(6)" ::: "memory");
      else asm volatile("s_waitcnt vmcnt(0)" ::: "memory");
      asm volatile("s_waitcnt lgkmcnt(0)" ::: "memory");
      __builtin_amdgcn_s_barrier();
      cur3 = (cur3 == 2) ? 0 : cur3 + 1;
      nxt3 = (nxt3 == 2) ? 0 : nxt3 + 1;
    } else {
      asm volatile("s_waitcnt vmcnt(0)" ::: "memory");
      __syncthreads();
    }
  }
#undef G_STAGE
}

DI void rowscale_prologue(const u16* Ab, int lda, int K, float* rs) {
  const int tid = tid_(), row = tid >> 1, half = tid & 1;
  const u16* p = Ab + (long)row * lda + half * (K >> 1);
  float ss = 0.f;
  for (int i = 0; i < (K >> 4); ++i) {
    i32x4 v = *(const i32x4*)(p + i * 8);
#pragma unroll
    for (int e = 0; e < 4; ++e) {
      float a = bflo((unsigned)v[e]), b = bfhi((unsigned)v[e]);
      ss += a * a + b * b;
    }
  }
  ss += __shfl_xor(ss, 1);
  if (half == 0) rs[row] = rsqrtf(ss / (float)K + EPS);
  __syncthreads();
}

DI void vt_store(u16* VT, int h, int dv, int row0, f32x4 v) {
  const int b = row0 >> 13, s0 = row0 & 8191;
  const int m32 = s0 >> 5, half = (s0 >> 4) & 1, fq = (s0 >> 2) & 3;
  const int sp = m32 * 32 + fq * 8 + half * 4;
  u32x2 o = {pack2(v[0], v[1]), pack2(v[2], v[3])};
  *(u32x2*)(VT + ((long)((b * 4 + h) * 128 + dv)) * SEQ + sp) = o;
}

struct TJob { const float* src; int ld, K, N, Npad; u16* dst; const float* rs; };
DI TJob get_job(const Params& P, int l, int j, u16* W) {
  TJob t;
  switch (j) {
    case 0: t = TJob{P.w_in + (size_t)l * 1024 * 9664, 9664, 1024, 3008, 3072, W + W_IN, P.norm_g + l * 1024}; break;
    case 1: t = TJob{P.w_in + (size_t)l * 1024 * 9664 + 3008, 9664, 1024, 6656, 6656, W + W_IN + (size_t)3072 * 1024, P.norm_g + l * 1024}; break;
    case 2: t = TJob{P.w_a_out + (size_t)l * 512 * 1024, 1024, 512, 1024, 1024, W + W_A, nullptr}; break;
    case 3: t = TJob{P.w_b_out + (size_t)l * 512 * 1024, 1024, 512, 1024, 1024, W + W_B, nullptr}; break;
    case 4: t = TJob{P.w_c_out + (size_t)l * 512 * 1024, 1024, 512, 1024, 1024, W + W_C, nullptr}; break;
    case 5: t = TJob{P.w_d_out + (size_t)l * 512 * 1024, 1024, 512, 1024, 1024, W + W_D, nullptr}; break;
    case 6: t = TJob{P.w_o + (size_t)l * 1024 * 1024, 1024, 1024, 1024, 1024, W + W_O, nullptr}; break;
    case 7: t = TJob{P.w_ple + (size_t)l * 256 * 1024, 1024, 256, 1024, 1024, W + W_PLE, nullptr}; break;
    case 8: t = TJob{P.w_ple_gate + (size_t)l * 1024 * 1024, 1024, 1024, 1024, 1024, W + W_G, P.ple_norm_g + l * 1024}; break;
    case 9: t = TJob{P.w_uq + (size_t)l * 256 * 768, 768, 256, 768, 768, W + W_UQ, P.cq_norm_g + l * 256}; break;
    default: t = TJob{P.w_ukv + (size_t)l * 128 * 1024, 1024, 128, 1024, 1024, W + W_UKV, P.ckv_norm_g + l * 128}; break;
  }
  return t;
}

DI void phase_prep(const Params& P, int l, char* shm) {
  u16* W = (u16*)(P.ws + OFF_W);
  float* tile = (float*)shm;
  const int tid = tid_();
  constexpr int NT0 = 16 * 48, NT1 = 16 * 104, NTA = 8 * 16, NTO = 16 * 16, NTP = 4 * 16, NTQ = 4 * 12, NTK = 2 * 16;
  constexpr int TOT = NT0 + NT1 + 4 * NTA + NTO + NTP + NTO + NTQ + NTK;
  for (int ft = blockIdx.x; ft < TOT; ft += gridDim.x) {
    int j, tl = ft;
    if (tl < NT0) j = 0;
    else if ((tl -= NT0) < NT1) j = 1;
    else if ((tl -= NT1) < 4 * NTA) { j = 2 + tl / NTA; tl %= NTA; }
    else if ((tl -= 4 * NTA) < NTO) j = 6;
    else if ((tl -= NTO) < NTP) j = 7;
    else if ((tl -= NTP) < NTO) j = 8;
    else if ((tl -= NTO) < NTQ) j = 9;
    else { tl -= NTQ; j = 10; }
    TJob J = get_job(P, l, j, W);
    const int nk = J.K >> 6;
    {
      const int tk = tl % nk, tn = tl / nk;
#pragma unroll
      for (int i = 0; i < 2; ++i) {
        int idx = tid + i * 512, kk = idx >> 4, n4 = (idx & 15) * 4;
        int n = tn * 64 + n4, k = tk * 64 + kk;
        float4 v = make_float4(0.f, 0.f, 0.f, 0.f);
        if (n < J.N) {
          v = *(const float4*)(J.src + (size_t)k * J.ld + n);
          if (J.rs) { float s = J.rs[k]; v.x *= s; v.y *= s; v.z *= s; v.w *= s; }
        }
        float* d = tile + kk * 65 + n4;
        d[0] = v.x; d[1] = v.y; d[2] = v.z; d[3] = v.w;
      }
      __syncthreads();
      {
        int nl = tid >> 3, k8 = (tid & 7) * 8;
        const float* s = tile + k8 * 65 + nl;
        i32x4 o;
        o[0] = (int)pack2(s[0], s[65]);
        o[1] = (int)pack2(s[130], s[195]);
        o[2] = (int)pack2(s[260], s[325]);
        o[3] = (int)pack2(s[390], s[455]);
        *(i32x4*)(J.dst + (size_t)(tn * 64 + nl) * J.K + tk * 64 + k8) = o;
      }
      __syncthreads();
    }
  }
  const int gtid = blockIdx.x * 512 + tid, gn = gridDim.x * 512;
  {
    const float* src = P.sgu_w + (size_t)l * 65536;
    u16* dst = W + W_SGU;
    for (int i = gtid; i < 65536; i += gn) {
      int s = i & 127, t = (i >> 7) & 127;
      dst[i] = ((s >> 6) <= (t >> 6)) ? f2bf(src[i]) : (u16)0;
    }
  }
  {
    const float* pw = P.pool_w + (size_t)l * 65536;
    const float* sc = P.pool_scale + l * 512;
    u16* dst = W + W_POOL;
    for (int i = gtid; i < 262144; i += gn) {
      int n = i >> 9, k = i & 511, g = n >> 7, d = n & 127, g2 = k >> 7, c = k & 127;
      dst[i] = (g == g2) ? f2bf(pw[(g * 128 + c) * 128 + d] * sc[n]) : (u16)0;
    }
  }
  {
    const float* src = P.p + (size_t)l * T_TOK * 256;
    u16* dst = (u16*)(P.ws + OFF_PB);
    for (int i = gtid; i < T_TOK * 256 / 8; i += gn) {
      float4 a = *(const float4*)(src + (size_t)i * 8), b = *(const float4*)(src + (size_t)i * 8 + 4);
      i32x4 o;
      o[0] = (int)pack2(a.x, a.y); o[1] = (int)pack2(a.z, a.w); o[2] = (int)pack2(b.x, b.y); o[3] = (int)pack2(b.z, b.w);
      *(i32x4*)(dst + (size_t)i * 8) = o;
    }
  }
}

DI void phase_rope(const Params& P) {
  float2* tab = (float2*)(P.ws + OFF_ROPE);
  const int gtid = blockIdx.x * 512 + tid_(), gn = gridDim.x * 512;
  for (int i = gtid; i < T_TOK * 32; i += gn) {
    const int t = i >> 5, f = i & 31;
    const float freq = exp2f(-(float)f * (13.287712379549449f / 32.f));
    const float ang = (float)P.pos[t] * freq;
    tab[i] = make_float2(cosf(ang), sinf(ang));
  }
}

DI void phase_norm(const float* xin, u16* hb) {
  const int lane = tid_() & 63, gw = blockIdx.x * 8 + (tid_() >> 6), nw = gridDim.x * 8;
  for (int t = gw; t < T_TOK; t += nw) {
    const float* r = xin + (size_t)t * DM;
    float4 v[4];
    float ss = 0.f;
#pragma unroll
    for (int i = 0; i < 4; ++i) {
      v[i] = *(const float4*)(r + i * 256 + lane * 4);
      ss += v[i].x * v[i].x + v[i].y * v[i].y + v[i].z * v[i].z + v[i].w * v[i].w;
    }
#pragma unroll
    for (int o = 32; o > 0; o >>= 1) ss += __shfl_xor(ss, o);
    const float rs = rsqrtf(ss * (1.f / DM) + EPS);
#pragma unroll
    for (int i = 0; i < 4; ++i) {
      u32x2 o = {pack2(v[i].x * rs, v[i].y * rs), pack2(v[i].z * rs, v[i].w * rs)};
      *(u32x2*)(hb + (size_t)t * DM + i * 256 + lane * 4) = o;
    }
  }
}

template <int MODE>
DI void phase_inproj(const Params& P, char* shm) {
  const u16* hb = (const u16*)(P.ws + OFF_HB);
  const u16* W = (const u16*)(P.ws + OFF_W) + W_IN;
  constexpr int wrow = MODE == 0 ? WR_C : MODE == 1 ? WR_D : MODE == 2 ? WR_A : WR_B;
  constexpr int nN = MODE == 0 ? 4 : MODE == 1 ? 8 : MODE == 2 ? 6 : 4;
  constexpr int SILU0 = MODE == 0 ? 512 : MODE == 1 ? 1536 : MODE == 2 ? 1024 : 512;
  const int tid = tid_(), lane = tid & 63, wid = tid >> 6, wr = wid >> 2, wc = wid & 3, fr = lane & 15, fq = lane >> 4;
  for (int tl = blockIdx.x; tl < 128 * nN; tl += gridDim.x) {
    int pm, pn;
    tile_map(tl, 128, nN, pm, pn);
    const int brow = pm * 256, bcol = pn * 256;
    f32x4 acc[8][4];
    const bool vt = (MODE == 1) && bcol >= 1024 && bcol < 1536;
    const bool silu = bcol >= SILU0;
    if (vt) {
      gemm_main<8, 4, false>(acc, hb + (size_t)brow * DM, DM, W + (size_t)(wrow + bcol) * DM, DM, DM, shm);
#pragma unroll
      for (int m = 0; m < 8; ++m)
#pragma unroll
        for (int n = 0; n < 4; ++n) {
          const int dv = wc * 64 + n * 16 + fr;
          const int p = (wr * 4 + (m >> 1)) * 32 + fq * 8 + (m & 1) * 4;
          u32x2 o = {pack2(acc[m][n][0], acc[m][n][1]), pack2(acc[m][n][2], acc[m][n][3])};
          *(u32x2*)(shm + dv * 528 + p * 2) = o;
        }
    } else {
      gemm_main<8, 4, true>(acc, hb + (size_t)brow * DM, DM, W + (size_t)(wrow + bcol) * DM, DM, DM, shm);
#pragma unroll
      for (int m = 0; m < 8; ++m)
#pragma unroll
        for (int n = 0; n < 4; ++n) {
          const int row = wr * 128 + m * 16 + fr, col = wc * 64 + n * 16 + fq * 4;
          f32x4 v = acc[m][n];
          if (silu) { v[0] = siluf_(v[0]); v[1] = siluf_(v[1]); v[2] = siluf_(v[2]); v[3] = siluf_(v[3]); }
          u32x2 o = {pack2(v[0], v[1]), pack2(v[2], v[3])};
          *(u32x2*)(shm + row * 528 + col * 2) = o;
        }
    }
    __syncthreads();
#pragma unroll 4
    for (int i = 0; i < 16; ++i) {
      const int chunk = tid_() + i * 512, row = chunk >> 5, c8 = (chunk & 31) * 8;
      const i32x4 v = *(const i32x4*)(shm + row * 528 + c8 * 2);
      const int gcol = bcol + c8;
      u16* d = nullptr;
      if (MODE == 0) {
        if (gcol < 448) d = (u16*)(P.ws + OFF_PROJC) + (size_t)(brow + row) * 448 + gcol;
        else if (gcol >= 512) d = (u16*)(P.ws + OFF_ACTC) + (size_t)(brow + row) * 512 + (gcol - 512);
      } else if (MODE == 1) {
        if (gcol < 1024) d = (u16*)(P.ws + OFF_PROJD) + (size_t)(brow + row) * 1024 + gcol;
        else if (gcol < 1536) {
          const int c2 = gcol - c8 - 1024 + row;
          const int b = brow >> 13, s0 = brow & 8191;
          d = (u16*)(P.ws + OFF_VTD) + ((size_t)((b * 4 + (c2 >> 7)) * 128 + (c2 & 127))) * SEQ + s0 + c8;
        } else d = (u16*)(P.ws + OFF_ACTD) + (size_t)(brow + row) * 512 + (gcol - 1536);
      } else if (MODE == 2) {
        if (gcol < 1024) d = (u16*)(P.ws + OFF_PROJA) + (size_t)(brow + row) * 1024 + gcol;
        else d = (u16*)(P.ws + OFF_ACTA) + (size_t)(brow + row) * 512 + (gcol - 1024);
      } else {
        if (gcol < 512) d = (u16*)(P.ws + OFF_PROJB) + (size_t)(brow + row) * 512 + gcol;
        else d = (u16*)(P.ws + OFF_ACTB) + (size_t)(brow + row) * 512 + (gcol - 512);
      }
      if (d) *(i32x4*)d = v;
    }
    __syncthreads();
  }
}

DI void phase_mla_up(const Params& P, int l, char* shm) {
  const u16* projC = (const u16*)(P.ws + OFF_PROJC);
  const float* kng = P.k_norm_g + l * 192;
  const u16* W = (const u16*)(P.ws + OFF_W);
  float* rs = (float*)(shm + 137216);
  const int tid = tid_(), lane = tid & 63, wid = tid >> 6, wr = wid >> 2, wc = wid & 3, fr = lane & 15, fq = lane >> 4;
  for (int tl = blockIdx.x; tl < 128 * 4; tl += gridDim.x) {
    int pm, pn;
    tile_map(tl, 128, 4, pm, pn);
    const int brow = pm * 256, bcol = pn * 256, h = pn;
    const u16* Ab = projC + (size_t)brow * 448 + 256;
    rowscale_prologue(Ab, 448, 128, rs);
    f32x4 acc[8][4];
    gemm_main<8, 4, false>(acc, Ab, 448, W + W_UKV + (size_t)bcol * 128, 128, 128, shm);
#pragma unroll
    for (int m = 0; m < 8; ++m) {
      const int rl = wr * 128 + m * 16 + fq * 4;
      const f32x4 sc = *(const f32x4*)(rs + rl);
#pragma unroll
      for (int n = 0; n < 4; ++n) {
        const f32x4 v = acc[m][n] * sc;
        if (wc < 2) {
          const int col = wc * 64 + n * 16 + fr;
#pragma unroll
          for (int j = 0; j < 4; ++j) *(u16*)(shm + (rl + j) * 272 + col * 2) = f2bf(v[j]);
        } else {
          const int dv = (wc - 2) * 64 + n * 16 + fr;
          const int p = (wr * 4 + (m >> 1)) * 32 + fq * 8 + (m & 1) * 4;
          u32x2 o = {pack2(v[0], v[1]), pack2(v[2], v[3])};
          *(u32x2*)(shm + 69632 + dv * 528 + p * 2) = o;
        }
      }
    }
    __syncthreads();
    {
      const int b = brow >> 13, s0 = brow & 8191;
#pragma unroll 2
      for (int i = 0; i < 8; ++i) {
        const int chunk = tid_() + i * 512, row = chunk >> 4, j16 = chunk & 15, c8 = j16 * 8, t = brow + row;
        const i32x4 v = *(const i32x4*)(shm + row * 272 + c8 * 2);
        const u32x2 krr = *(const u32x2*)(projC + (size_t)t * 448 + 384 + j16 * 4);
        float kv[8], kr[4];
#pragma unroll
        for (int e = 0; e < 4; ++e) { kv[2 * e] = bflo((unsigned)v[e]); kv[2 * e + 1] = bfhi((unsigned)v[e]); }
        kr[0] = bflo(krr[0]); kr[1] = bfhi(krr[0]); kr[2] = bflo(krr[1]); kr[3] = bfhi(krr[1]);
        float ss = 0.f;
#pragma unroll
        for (int e = 0; e < 8; ++e) ss += kv[e] * kv[e];
#pragma unroll
        for (int e = 0; e < 4; ++e) ss += kr[e] * kr[e];
        ss += __shfl_xor(ss, 1); ss += __shfl_xor(ss, 2); ss += __shfl_xor(ss, 4); ss += __shfl_xor(ss, 8);
        const float r = rsqrtf(ss * (1.f / 192.f) + EPS);
        u16* kd = (u16*)(P.ws + OFF_KC) + ((size_t)((b * 4 + h) * SEQ + s0 + row)) * 192;
        const f32x4 g0 = *(const f32x4*)(kng + c8), g1 = *(const f32x4*)(kng + c8 + 4);
        i32x4 o;
        o[0] = (int)pack2(kv[0] * r * g0[0], kv[1] * r * g0[1]);
        o[1] = (int)pack2(kv[2] * r * g0[2], kv[3] * r * g0[3]);
        o[2] = (int)pack2(kv[4] * r * g1[0], kv[5] * r * g1[1]);
        o[3] = (int)pack2(kv[6] * r * g1[2], kv[7] * r * g1[3]);
        *(i32x4*)(kd + c8) = o;
        const f32x4 gr = *(const f32x4*)(kng + 128 + j16 * 4);
        const f32x4* rt = (const f32x4*)(P.ws + OFF_ROPE) + (size_t)t * 16 + (j16 & 7) * 2;
        const f32x4 cs01 = rt[0], cs23 = rt[1];
        float my[4], ot[4], rv[4];
#pragma unroll
        for (int e = 0; e < 4; ++e) { my[e] = kr[e] * r * gr[e]; ot[e] = __shfl_xor(my[e], 8); }
        const float sgn = (j16 < 8) ? -1.f : 1.f;
        rv[0] = my[0] * cs01[0] + sgn * ot[0] * cs01[1];
        rv[1] = my[1] * cs01[2] + sgn * ot[1] * cs01[3];
        rv[2] = my[2] * cs23[0] + sgn * ot[2] * cs23[1];
        rv[3] = my[3] * cs23[2] + sgn * ot[3] * cs23[3];
        u32x2 ro = {pack2(rv[0], rv[1]), pack2(rv[2], rv[3])};
        *(u32x2*)(kd + 128 + j16 * 4) = ro;
      }
#pragma unroll 4
      for (int i = 0; i < 8; ++i) {
        const int chunk = tid_() + i * 512, dv = chunk >> 5, c8 = (chunk & 31) * 8;
        const i32x4 v = *(const i32x4*)(shm + 69632 + dv * 528 + c8 * 2);
        *(i32x4*)((u16*)(P.ws + OFF_VTC) + ((size_t)((b * 4 + h) * 128 + dv)) * SEQ + s0 + c8) = v;
      }
    }
    __syncthreads();
  }
  for (int tl = blockIdx.x; tl < 128 * 3; tl += gridDim.x) {
    int pm, pn;
    tile_map(tl, 128, 3, pm, pn);
    const int brow = pm * 256, bcol = pn * 256;
    const u16* Ab = projC + (size_t)brow * 448;
    rowscale_prologue(Ab, 448, 256, rs);
    f32x4 acc[8][4];
    gemm_main<8, 4>(acc, Ab, 448, W + W_UQ + (size_t)bcol * 256, 256, 256, shm);
#pragma unroll
    for (int m = 0; m < 8; ++m) {
      const int rl = wr * 128 + m * 16 + fr;
      const float sc = rs[rl];
#pragma unroll
      for (int n = 0; n < 4; ++n) {
        const int col = wc * 64 + n * 16 + fq * 4;
        const f32x4 v = acc[m][n] * sc;
        u32x2 o = {pack2(v[0], v[1]), pack2(v[2], v[3])};
        *(u32x2*)(shm + rl * 528 + col * 2) = o;
      }
    }
    __syncthreads();
#pragma unroll 4
    for (int i = 0; i < 16; ++i) {
      const int chunk = tid_() + i * 512, row = chunk >> 5, c8 = (chunk & 31) * 8;
      const i32x4 v = *(const i32x4*)(shm + row * 528 + c8 * 2);
      *(i32x4*)((u16*)(P.ws + OFF_QRAW) + (size_t)(brow + row) * 768 + bcol + c8) = v;
    }
    __syncthreads();
  }
}

DI void phase_kprep(const Params& P, int l, int dry = 0) {
  const int lane = tid_() & 63, gw = blockIdx.x * 8 + (tid_() >> 6), nw = gridDim.x * 8;
  const float* g = P.k_norm_g + l * 192;
  const u16* projC = (const u16*)(P.ws + OFF_PROJC);
  u16* Kc = (u16*)(P.ws + OFF_KC);
  const float g0 = g[2 * lane], g1 = g[2 * lane + 1];
  const float gr1 = g[128 + (lane & 31)], gr2 = g[160 + (lane & 31)];
  for (int it = gw; it < T_TOK * 4; it += nw) {
    const int t = it >> 2, h = it & 3, b = t >> 13, s = t & 8191;
    u16* kr = Kc + ((size_t)((b * 4 + h) * SEQ + s)) * 192;
    const unsigned kv = *(const unsigned*)(kr + 2 * lane);
    float v0 = bflo(kv), v1 = bfhi(kv);
    float r1 = 0.f, r2 = 0.f;
    if (lane < 32) {
      r1 = bf2f(projC[(size_t)t * 448 + 384 + lane]);
      r2 = bf2f(projC[(size_t)t * 448 + 416 + lane]);
    }
    float ss = v0 * v0 + v1 * v1 + r1 * r1 + r2 * r2;
#pragma unroll
    for (int o = 32; o > 0; o >>= 1) ss += __shfl_xor(ss, o);
    const float r = rsqrtf(ss * (1.f / 192.f) + EPS);
    if (!dry) *(unsigned*)(kr + 2 * lane) = pack2(v0 * r * g0, v1 * r * g1);
    if (lane < 32 && !dry) {
      const float2 cssn = ((const float2*)(P.ws + OFF_ROPE))[(size_t)t * 32 + lane];
      const float cs = cssn.x, sn = cssn.y;
      const float x1 = r1 * r * gr1, x2 = r2 * r * gr2;
      kr[128 + lane] = f2bf(x1 * cs - x2 * sn);
      kr[160 + lane] = f2bf(x2 * cs + x1 * sn);
    }
  }
}

DI void phase_attn_d(const Params& P, char* shm, int dry = 0) {
  constexpr int KT_B = 16384, VT_B = 16384, BUF_B = KT_B + VT_B;
  const int tid = tid_();
  const int wid = __builtin_amdgcn_readfirstlane(tid >> 6), lane = tid & 63, fr = lane & 15, fq = lane >> 4;
  const u16* projD = (const u16*)(P.ws + OFF_PROJD);
  const u16* VT = (const u16*)(P.ws + OFF_VTD);
  u16* actD = (u16*)(P.ws + OFF_ACTD);
  volatile int* sdone = (volatile int*)(shm + 2 * BUF_B);
  const float sc = 0.08838834764831845f;
  int kR[2], kC[2], vR[2], vC[2];
#pragma unroll
  for (int i = 0; i < 2; ++i) {
    stage_rc<4>((tid + i * 512) * 16, kR[i], kC[i]);
    stage_rc<2>((tid + i * 512) * 16, vR[i], vC[i]);
  }
  int pk[2], pv[2];
#pragma unroll
  for (int i = 0; i < 2; ++i) { pk[i] = kR[i] * 1024 + kC[i]; pv[i] = vR[i] * SEQ + vC[i]; }
  const int kf_off = lds_byte<4>(fr, fq * 8), vf_off = lds_byte<2>(fr, fq * 8);
  for (int it = blockIdx.x; it < 16 * 64; it += gridDim.x) {
    const int bh = it >> 6, qb = it & 63, b = bh >> 2, h = bh & 3, T0 = qb * 128, t0 = T0 + wid * 16;
    const u16* Kg = projD + (size_t)(b * SEQ) * 1024 + 512 + h * 128;
    const u16* Vg = VT + (size_t)(bh * 128) * SEQ;
#define D_STAGE(buf, kb_)                                                                                  \
  do {                                                                                                     \
    _Pragma("unroll") for (int i = 0; i < 2; ++i) __builtin_amdgcn_global_load_lds(                        \
        (const unsigned*)(Kg + (pk[i] + (kb_) * 1024)), (unsigned*)(shm + (buf) * BUF_B + wid * 1024 + i * 8192), 16, 0, 0); \
    _Pragma("unroll") for (int i = 0; i < 2; ++i) __builtin_amdgcn_global_load_lds(                        \
        (const unsigned*)(Vg + (pv[i] + (kb_))), (unsigned*)(shm + (buf) * BUF_B + KT_B + wid * 1024 + i * 8192), 16, 0, 0); \
  } while (0)
    const int kb_top = T0 + 64;
    D_STAGE(0, kb_top);
    const u16* qp = projD + (size_t)(b * SEQ + t0 + fr) * 1024 + h * 128 + fq * 8;
    bf16x8 qf[4];
#pragma unroll
    for (int ks = 0; ks < 4; ++ks) qf[ks] = *(const bf16x8*)(qp + ks * 32);
    f32x4 o[8];
#pragma unroll
    for (int i = 0; i < 8; ++i) o[i] = f32x4{0.f, 0.f, 0.f, 0.f};
    float R = 0.f;
    const int tq = t0 + fr;
    const int kbw = (t0 >> 6) << 6;
    int done = 0;
    asm volatile("s_waitcnt vmcnt(0)" ::: "memory");
    __syncthreads();
    int iter = 0;
#pragma clang loop unroll(disable)
    for (int kb = kb_top;; kb -= 64, ++iter) {
      const int cur = iter & 1;
      const bool more = kb >= 64;
      if (more) D_STAGE(cur ^ 1, kb - 64);
      if (!done && kb <= kbw) {
        const char* Kf = shm + cur * BUF_B + kf_off;
        const char* Vf = shm + cur * BUF_B + KT_B + vf_off;
        f32x4 z[4];
#pragma unroll
        for (int sub = 0; sub < 4; ++sub) {
          z[sub] = f32x4{0.f, 0.f, 0.f, 0.f};
#pragma unroll
          for (int ks = 0; ks < 4; ++ks) {
            const bf16x8 kf = *(const bf16x8*)(Kf + sub * 4096 + ks * 1024);
            z[sub] = MFMA16(kf, qf[ks], z[sub]);
          }
        }
        float lk[4][4], lz[4][4], loc[4];
#pragma unroll
        for (int sub = 0; sub < 4; ++sub) {
          loc[sub] = 0.f;
#pragma unroll
          for (int j = 0; j < 4; ++j) {
            const int key = kb + sub * 16 + fq * 4 + j;
            const bool valid = key < tq;
            const float zv = z[sub][j] * sc;
            const float sp = fmaxf(zv, 0.f) + __logf(1.f + __expf(-fabsf(zv)));
            lk[sub][j] = valid ? -sp : 0.f;
            lz[sub][j] = valid ? (zv - sp) : -1e30f;
            loc[sub] += lk[sub][j];
          }
        }
        float run = R;
        float a[4][4];
#pragma unroll
        for (int sub = 3; sub >= 0; --sub) {
          const float p = __shfl_xor(loc[sub], 16);
          const float pr = loc[sub] + p;
          const float c = __shfl_xor(pr, 32);
          const float suf_in = (fq == 3) ? 0.f : (fq == 2) ? p : (fq == 1) ? c : (p + c);
          float af = run + suf_in;
#pragma unroll
          for (int j = 3; j >= 0; --j) {
            a[sub][j] = __expf(lz[sub][j] + af);
            af += lk[sub][j];
          }
          run += pr + c;
        }
        R = run;
        bf16x8 pf[2];
#pragma unroll
        for (int kk = 0; kk < 2; ++kk) {
          i32x4 pkk;
          pkk[0] = (int)pack2(a[2 * kk][0], a[2 * kk][1]);
          pkk[1] = (int)pack2(a[2 * kk][2], a[2 * kk][3]);
          pkk[2] = (int)pack2(a[2 * kk + 1][0], a[2 * kk + 1][1]);
          pkk[3] = (int)pack2(a[2 * kk + 1][2], a[2 * kk + 1][3]);
          pf[kk] = __builtin_bit_cast(bf16x8, pkk);
        }
#pragma unroll
        for (int dvs = 0; dvs < 8; ++dvs) {
          const bf16x8 v0 = *(const bf16x8*)(Vf + dvs * 2048);
          const bf16x8 v1 = *(const bf16x8*)(Vf + dvs * 2048 + 1024);
          o[dvs] = MFMA16(v0, pf[0], o[dvs]);
          o[dvs] = MFMA16(v1, pf[1], o[dvs]);
        }
        if (__all(R < -104.f)) done = 1;
      }
      if (lane == 0) sdone[cur * 8 + wid] = done;
      asm volatile("s_waitcnt vmcnt(0)" ::: "memory");
      __syncthreads();
      int alld = 1;
#pragma unroll
      for (int w = 0; w < 8; ++w) alld &= sdone[cur * 8 + w];
      if (alld || !more) break;
    }
#undef D_STAGE
    u16* dp = actD + (size_t)(b * SEQ + t0 + fr) * 512 + h * 128 + fq * 4;
#pragma unroll
    for (int dvs = 0; dvs < 8; ++dvs) {
      u32x2 gz = *(const u32x2*)(dp + dvs * 16);
      u32x2 ov = {pack2(o[dvs][0] * bflo(gz[0]), o[dvs][1] * bfhi(gz[0])),
                  pack2(o[dvs][2] * bflo(gz[1]), o[dvs][3] * bfhi(gz[1]))};
      if (!dry) *(u32x2*)(dp + dvs * 16) = ov;
    }
    __syncthreads();
  }
}

DI void attn_c_item(const Params& P, int l, int b, int h, int qb, char* shm, float B2, int dry) {
  const int tid = tid_();
  const int wid = __builtin_amdgcn_readfirstlane(tid >> 6), lane = tid & 63, fr = lane & 15, fq = lane >> 4;
  const u16* Kg = (const u16*)(P.ws + OFF_KC) + (size_t)((b * 4 + h) * SEQ) * 192;
  const u16* Vg = (const u16*)(P.ws + OFF_VTC) + (size_t)((b * 4 + h) * 128) * SEQ;
  const u16* qraw = (const u16*)(P.ws + OFF_QRAW);
  const float* qg = P.q_norm_g + l * 192;
  const int q0 = qb * 256 + wid * 32;
  bf16x8 qf[2][6];
  const float qscale = 0.07216878364870323f * 1.4426950408889634f;
#pragma unroll
  for (int qs = 0; qs < 2; ++qs) {
    const int t = b * SEQ + q0 + qs * 16 + fr;
    const u16* qp = qraw + (size_t)t * 768 + h * 192 + fq * 8;
    float v[6][8];
    float ss = 0.f;
#pragma unroll
    for (int ks = 0; ks < 6; ++ks) {
      i32x4 raw = *(const i32x4*)(qp + ks * 32);
#pragma unroll
      for (int e = 0; e < 4; ++e) {
        v[ks][2 * e] = bflo((unsigned)raw[e]);
        v[ks][2 * e + 1] = bfhi((unsigned)raw[e]);
        ss += v[ks][2 * e] * v[ks][2 * e] + v[ks][2 * e + 1] * v[ks][2 * e + 1];
      }
    }
    ss += __shfl_xor(ss, 16);
    ss += __shfl_xor(ss, 32);
    const float r = rsqrtf(ss * (1.f / 192.f) + EPS);
#pragma unroll
    for (int ks = 0; ks < 6; ++ks)
#pragma unroll
      for (int e = 0; e < 8; ++e) v[ks][e] *= r * qg[ks * 32 + fq * 8 + e];
    const f32x4* rt = (const f32x4*)(P.ws + OFF_ROPE) + (size_t)t * 16 + fq * 4;
#pragma unroll
    for (int e2 = 0; e2 < 4; ++e2) {
      const f32x4 cssn = rt[e2];
#pragma unroll
      for (int u = 0; u < 2; ++u) {
        const int e = e2 * 2 + u;
        const float cs = cssn[2 * u], sn = cssn[2 * u + 1];
        const float x1 = v[4][e], x2 = v[5][e];
        v[4][e] = x1 * cs - x2 * sn;
        v[5][e] = x2 * cs + x1 * sn;
      }
    }
#pragma unroll
    for (int ks = 0; ks < 6; ++ks) {
      i32x4 pk;
#pragma unroll
      for (int e = 0; e < 4; ++e) pk[e] = (int)pack2(v[ks][2 * e] * qscale, v[ks][2 * e + 1] * qscale);
      qf[qs][ks] = __builtin_bit_cast(bf16x8, pk);
    }
  }
  constexpr int KT_B = 24576, VT_B = 16384, BUF_B = KT_B + VT_B;
  const int ntile = qb * 4 + 4;
  const int my_last = qb * 4 + (wid >> 1);
  f32x4 o[8][2];
#pragma unroll
  for (int i = 0; i < 8; ++i) { o[i][0] = f32x4{0.f, 0.f, 0.f, 0.f}; o[i][1] = f32x4{0.f, 0.f, 0.f, 0.f}; }
  float lsum[2] = {0.f, 0.f};
  int kR[3], kC[3], vR[2], vC[2];
#pragma unroll
  for (int i = 0; i < 3; ++i) stage_rc<6>((tid + i * 512) * 16, kR[i], kC[i]);
#pragma unroll
  for (int i = 0; i < 2; ++i) stage_rc<2>((tid + i * 512) * 16, vR[i], vC[i]);
  int pk[3], pv[2];
#pragma unroll
  for (int i = 0; i < 3; ++i) pk[i] = kR[i] * 192 + kC[i];
#pragma unroll
  for (int i = 0; i < 2; ++i) pv[i] = vR[i] * SEQ + vC[i];
#define A_STAGE(buf, kt)                                                                                 \
  do {                                                                                                   \
    _Pragma("unroll") for (int i = 0; i < 3; ++i) __builtin_amdgcn_global_load_lds(                      \
        (const unsigned*)(Kg + (pk[i] + (kt) * 64 * 192)), (unsigned*)(shm + (buf) * BUF_B + wid * 1024 + i * 8192), 16, 0, 0); \
    _Pragma("unroll") for (int i = 0; i < 2; ++i) __builtin_amdgcn_global_load_lds(                      \
        (const unsigned*)(Vg + (pv[i] + (kt) * 64)), (unsigned*)(shm + (buf) * BUF_B + KT_B + wid * 1024 + i * 8192), 16, 0, 0); \
  } while (0)
  A_STAGE(0, 0);
  asm volatile("s_waitcnt vmcnt(0)" ::: "memory");
  __syncthreads();
#pragma clang loop unroll(disable)
  for (int kt = 0; kt < ntile; ++kt) {
    const int cur = kt & 1;
    if (kt + 1 < ntile) A_STAGE(cur ^ 1, kt + 1);
    if (kt <= my_last) {
      const char* Kb = shm + cur * BUF_B;
      const char* Vb = Kb + KT_B;
      f32x4 s[4][2];
#pragma unroll
      for (int i = 0; i < 4; ++i) { s[i][0] = f32x4{0.f, 0.f, 0.f, 0.f}; s[i][1] = f32x4{0.f, 0.f, 0.f, 0.f}; }
      const char* Kf = Kb + lds_byte<6>(fr, fq * 8);
      const char* Vf = Vb + lds_byte<2>(fr, fq * 8);
      bf16x8 kf[2][4], vf0[8], vf1[8];
#pragma unroll
      for (int sub = 0; sub < 4; ++sub) kf[0][sub] = *(const bf16x8*)(Kf + sub * 6144);
#pragma unroll
      for (int ks = 0; ks < 6; ++ks) {
        if (ks < 5) {
#pragma unroll
          for (int sub = 0; sub < 4; ++sub) kf[(ks + 1) & 1][sub] = *(const bf16x8*)(Kf + sub * 6144 + (ks + 1) * 1024);
        } else {
#pragma unroll
          for (int dvs = 0; dvs < 8; ++dvs) vf0[dvs] = *(const bf16x8*)(Vf + dvs * 2048);
        }
#pragma unroll
        for (int sub = 0; sub < 4; ++sub) {
          s[sub][0] = MFMA16(kf[ks & 1][sub], qf[0][ks], s[sub][0]);
          s[sub][1] = MFMA16(kf[ks & 1][sub], qf[1][ks], s[sub][1]);
        }
      }
      __builtin_amdgcn_sched_group_barrier(0x100, 4, 0);
#pragma unroll
      for (int i = 0; i < 20; ++i) { __builtin_amdgcn_sched_group_barrier(0x100, 1, 0); __builtin_amdgcn_sched_group_barrier(0x008, 2, 0); }
#pragma unroll
      for (int i = 0; i < 4; ++i) { __builtin_amdgcn_sched_group_barrier(0x100, 2, 0); __builtin_amdgcn_sched_group_barrier(0x008, 2, 0); }
      __builtin_amdgcn_sched_barrier(0);
      bf16x8 pf[2][2];
#pragma unroll
      for (int qs = 0; qs < 2; ++qs) {
#pragma unroll
        for (int kk = 0; kk < 2; ++kk) {
          float pv[8];
#pragma unroll
          for (int j = 0; j < 4; ++j) {
            pv[j] = __builtin_amdgcn_exp2f(s[2 * kk][qs][j] - B2);
            pv[4 + j] = __builtin_amdgcn_exp2f(s[2 * kk + 1][qs][j] - B2);
          }
          lsum[qs] += ((pv[0] + pv[1]) + (pv[2] + pv[3])) + ((pv[4] + pv[5]) + (pv[6] + pv[7]));
          i32x4 pk;
#pragma unroll
          for (int e = 0; e < 4; ++e) pk[e] = (int)pack2(pv[2 * e], pv[2 * e + 1]);
          pf[kk][qs] = __builtin_bit_cast(bf16x8, pk);
        }
      }
      __builtin_amdgcn_sched_barrier(0);
#pragma unroll
      for (int dvs = 0; dvs < 8; ++dvs) vf1[dvs] = *(const bf16x8*)(Vf + dvs * 2048 + 1024);
#pragma unroll
      for (int dvs = 0; dvs < 8; ++dvs) {
        o[dvs][0] = MFMA16(vf0[dvs], pf[0][0], o[dvs][0]);
        o[dvs][1] = MFMA16(vf0[dvs], pf[0][1], o[dvs][1]);
      }
#pragma unroll
      for (int dvs = 0; dvs < 8; ++dvs) {
        o[dvs][0] = MFMA16(vf1[dvs], pf[1][0], o[dvs][0]);
        o[dvs][1] = MFMA16(vf1[dvs], pf[1][1], o[dvs][1]);
      }
#pragma unroll
      for (int i = 0; i < 8; ++i) { __builtin_amdgcn_sched_group_barrier(0x100, 1, 0); __builtin_amdgcn_sched_group_barrier(0x008, 2, 0); }
      __builtin_amdgcn_sched_group_barrier(0x008, 16, 0);
      __builtin_amdgcn_sched_barrier(0);
    }
    asm volatile("s_waitcnt vmcnt(0)" ::: "memory");
    __syncthreads();
  }
#undef A_STAGE
  u16* actC = (u16*)(P.ws + OFF_ACTC);
#pragma unroll
  for (int qs = 0; qs < 2; ++qs) {
    float lt = lsum[qs];
    lt += __shfl_xor(lt, 16);
    lt += __shfl_xor(lt, 32);
    const float inv = 1.f / lt;
    u16* dp = actC + (size_t)(b * SEQ + q0 + qs * 16 + fr) * 512 + h * 128 + fq * 4;
#pragma unroll
    for (int dvs = 0; dvs < 8; ++dvs) {
      u32x2 gz = *(const u32x2*)(dp + dvs * 16);
      u32x2 ov = {pack2(o[dvs][qs][0] * inv * bflo(gz[0]), o[dvs][qs][1] * inv * bfhi(gz[0])),
                  pack2(o[dvs][qs][2] * inv * bflo(gz[1]), o[dvs][qs][3] * inv * bfhi(gz[1]))};
      if (!dry) *(u32x2*)(dp + dvs * 16) = ov;
    }
  }
}

DI void phase_attn_c(const Params& P, int l, char* shm, int dry) {
  const int lane = tid_() & 63;
  float gq = 0.f, gk = 0.f;
#pragma unroll
  for (int i = 0; i < 3; ++i) {
    gq = fmaxf(gq, fabsf(P.q_norm_g[l * 192 + lane + i * 64]));
    gk = fmaxf(gk, fabsf(P.k_norm_g[l * 192 + lane + i * 64]));
  }
#pragma unroll
  for (int o = 32; o > 0; o >>= 1) { gq = fmaxf(gq, __shfl_xor(gq, o)); gk = fmaxf(gk, __shfl_xor(gk, o)); }
  const float B2 = 13.856406460551018f * 1.4426950408889634f * gq * gk;
  for (int it = blockIdx.x; it < 256; it += gridDim.x) {
    const int bh = it >> 4, pr = it & 15, b = bh >> 2, h = bh & 3;
#pragma clang loop unroll(disable)
    for (int hf = 0; hf < 2; ++hf) attn_c_item(P, l, b, h, hf ? pr : 31 - pr, shm, B2, dry);
  }
}

DI void phase_sgu(const Params& P, int l, char* shm, int dry = 0) {
  const int tid = tid_(), wid = tid >> 6, lane = tid & 63, fr = lane & 15, fq = lane >> 4;
  u16* vT = (u16*)shm;
  float* st = (float*)(shm + 128 * 136 * 2);
  const u16* projA = (const u16*)(P.ws + OFF_PROJA);
  u16* actA = (u16*)(P.ws + OFF_ACTA);
  const u16* Wsgu = (const u16*)(P.ws + OFF_W) + W_SGU;
  const float* lng = P.ln_v_g + l * 512;
  const float* lnb = P.ln_v_b + l * 512;
  const float* sb = P.sgu_b + l * 512;
  for (int nb = blockIdx.x; nb < 256; nb += gridDim.x) {
    const int T0 = nb * 128;
    {
      const int tok = tid >> 2, qu = tid & 3;
      const u16* p = projA + (size_t)(T0 + tok) * 1024 + 512 + qu * 128;
      float s1 = 0.f, s2 = 0.f;
#pragma unroll
      for (int i = 0; i < 16; ++i) {
        i32x4 v = *(const i32x4*)(p + i * 8);
#pragma unroll
        for (int e = 0; e < 4; ++e) {
          float a = bflo((unsigned)v[e]), c = bfhi((unsigned)v[e]);
          s1 += a + c;
          s2 += a * a + c * c;
        }
      }
      s1 += __shfl_xor(s1, 1); s2 += __shfl_xor(s2, 1);
      s1 += __shfl_xor(s1, 2); s2 += __shfl_xor(s2, 2);
      const float mean = s1 * (1.f / 512.f);
      const float var = fmaxf(s2 * (1.f / 512.f) - mean * mean, 0.f);
      if (qu == 0) { st[tok] = mean; st[128 + tok] = rsqrtf(var + EPS); }
    }
    __syncthreads();
    for (int g = 0; g < 4; ++g) {
      {
        const int s = tid >> 2, cq = tid & 3;
        const float mean = st[s], rstd = st[128 + s];
        const u16* p = projA + (size_t)(T0 + s) * 1024 + 512 + g * 128 + cq * 32;
#pragma unroll
        for (int i = 0; i < 4; ++i) {
          i32x4 v = *(const i32x4*)(p + i * 8);
#pragma unroll
          for (int e = 0; e < 4; ++e) {
            const int c = cq * 32 + i * 8 + 2 * e;
            float a = (bflo((unsigned)v[e]) - mean) * rstd * lng[g * 128 + c] + lnb[g * 128 + c];
            float d = (bfhi((unsigned)v[e]) - mean) * rstd * lng[g * 128 + c + 1] + lnb[g * 128 + c + 1];
            vT[c * 136 + s] = f2bf(a);
            vT[(c + 1) * 136 + s] = f2bf(d);
          }
        }
      }
      __syncthreads();
      f32x4 acc[8];
#pragma unroll
      for (int i = 0; i < 8; ++i) acc[i] = f32x4{0.f, 0.f, 0.f, 0.f};
      const u16* wp = Wsgu + (size_t)(g * 128 + wid * 16 + fr) * 128 + fq * 8;
#pragma unroll
      for (int ks = 0; ks < 4; ++ks) {
        bf16x8 af = *(const bf16x8*)(wp + ks * 32);
#pragma unroll
        for (int ns = 0; ns < 8; ++ns) {
          bf16x8 bfr = *(const bf16x8*)(vT + (ns * 16 + fr) * 136 + ks * 32 + fq * 8);
          acc[ns] = MFMA16(bfr, af, acc[ns]);
        }
      }
      {
        const int tl = wid * 16 + fr;
        const float bias = sb[g * 128 + tl];
        float* mx = (float*)(shm + 36864);
#pragma unroll
        for (int ns = 0; ns < 8; ++ns) {
          f32x4 v = acc[ns];
          v[0] += bias; v[1] += bias; v[2] += bias; v[3] += bias;
          *(f32x4*)(mx + tl * 132 + ns * 16 + fq * 4) = v;
        }
      }
      __syncthreads();
      {
        const float* mx = (const float*)(shm + 36864);
#pragma unroll
        for (int i = 0; i < 4; ++i) {
          const int chunk = tid + i * 512, tl = chunk >> 4, c8 = (chunk & 15) * 8, tt = T0 + tl;
          const f32x4 m0 = *(const f32x4*)(mx + tl * 132 + c8), m1 = *(const f32x4*)(mx + tl * 132 + c8 + 4);
          const i32x4 u = *(const i32x4*)(projA + (size_t)tt * 1024 + g * 128 + c8);
          u16* d = actA + (size_t)tt * 512 + g * 128 + c8;
          const i32x4 zg = *(const i32x4*)d;
          i32x4 o;
          o[0] = (int)pack2(bflo((unsigned)u[0]) * m0[0] * bflo((unsigned)zg[0]), bfhi((unsigned)u[0]) * m0[1] * bfhi((unsigned)zg[0]));
          o[1] = (int)pack2(bflo((unsigned)u[1]) * m0[2] * bflo((unsigned)zg[1]), bfhi((unsigned)u[1]) * m0[3] * bfhi((unsigned)zg[1]));
          o[2] = (int)pack2(bflo((unsigned)u[2]) * m1[0] * bflo((unsigned)zg[2]), bfhi((unsigned)u[2]) * m1[1] * bfhi((unsigned)zg[2]));
          o[3] = (int)pack2(bflo((unsigned)u[3]) * m1[2] * bflo((unsigned)zg[3]), bfhi((unsigned)u[3]) * m1[3] * bfhi((unsigned)zg[3]));
          if (!dry) *(i32x4*)d = o;
        }
      }
      __syncthreads();
    }
  }
}

DI void phase_pooled(const Params& P) {
  const u16* projB = (const u16*)(P.ws + OFF_PROJB);
  u16* pooled = (u16*)(P.ws + OFF_POOLED);
  const int gtid = blockIdx.x * 512 + tid_(), gn = gridDim.x * 512;
  for (int it = gtid; it < (T_TOK / 16) * 64; it += gn) {
    const int seg = it >> 6, c8 = it & 63, g = c8 >> 4, win = 2 << g, t0 = seg * 16, s0 = t0 & 8191;
    const u16* base = projB + (size_t)t0 * 512 + c8 * 8;
    float run[8];
#pragma unroll
    for (int e = 0; e < 8; ++e) run[e] = 0.f;
    for (int j = 1; j < win; ++j) {
      if (s0 - j >= 0) {
        const i32x4 v = *(const i32x4*)(base - (size_t)j * 512);
#pragma unroll
        for (int e = 0; e < 4; ++e) { run[2 * e] += bflo((unsigned)v[e]); run[2 * e + 1] += bfhi((unsigned)v[e]); }
      }
    }
#pragma unroll 4
    for (int i = 0; i < 16; ++i) {
      const i32x4 v = *(const i32x4*)(base + (size_t)i * 512);
      float x0[8];
#pragma unroll
      for (int e = 0; e < 4; ++e) {
        x0[2 * e] = bflo((unsigned)v[e]); x0[2 * e + 1] = bfhi((unsigned)v[e]);
        run[2 * e] += x0[2 * e]; run[2 * e + 1] += x0[2 * e + 1];
      }
      const int s = s0 + i;
      const float inv = 1.f / (float)min(s + 1, win);
      i32x4 o;
#pragma unroll
      for (int e = 0; e < 4; ++e) o[e] = (int)pack2(run[2 * e] * inv - x0[2 * e], run[2 * e + 1] * inv - x0[2 * e + 1]);
      *(i32x4*)(pooled + (size_t)(t0 + i) * 512 + c8 * 8) = o;
      if (s - win + 1 >= 0) {
        const i32x4 w = *(const i32x4*)(base + (size_t)(i - win + 1) * 512);
#pragma unroll
        for (int e = 0; e < 4; ++e) { run[2 * e] -= bflo((unsigned)w[e]); run[2 * e + 1] -= bfhi((unsigned)w[e]); }
      }
    }
  }
}

DI void phase_pool_gemm(const Params& P, char* shm) {
  const u16* pooled = (const u16*)(P.ws + OFF_POOLED);
  const u16* W = (const u16*)(P.ws + OFF_W) + W_POOL;
  u16* actB = (u16*)(P.ws + OFF_ACTB);
  const int tid = tid_(), lane = tid & 63, wid = tid >> 6, wr = wid >> 2, wc = wid & 3, fr = lane & 15, fq = lane >> 4;
  for (int tl = blockIdx.x; tl < 128 * 2; tl += gridDim.x) {
    int pm, pn;
    tile_map(tl, 128, 2, pm, pn);
    const int brow = pm * 256, bcol = pn * 256;
    f32x4 acc[8][4];
    gemm_main<8, 4>(acc, pooled + (size_t)brow * 512, 512, W + (size_t)bcol * 512, 512, 512, shm);
#pragma unroll
    for (int m = 0; m < 8; ++m)
#pragma unroll
      for (int n = 0; n < 4; ++n) {
        const int row = wr * 128 + m * 16 + fr, col = wc * 64 + n * 16 + fq * 4;
        u32x2 o = {pack2(acc[m][n][0], acc[m][n][1]), pack2(acc[m][n][2], acc[m][n][3])};
        *(u32x2*)(shm + row * 528 + col * 2) = o;
      }
    __syncthreads();
#pragma unroll 4
    for (int i = 0; i < 16; ++i) {
      const int chunk = tid_() + i * 512, row = chunk >> 5, c8 = (chunk & 31) * 8;
      const i32x4 v = *(const i32x4*)(shm + row * 528 + c8 * 2);
      u16* d = actB + (size_t)(brow + row) * 512 + bcol + c8;
      const i32x4 g = *(const i32x4*)d;
      i32x4 o;
#pragma unroll
      for (int e = 0; e < 4; ++e)
        o[e] = (int)pack2(bflo((unsigned)v[e]) * bflo((unsigned)g[e]), bfhi((unsigned)v[e]) * bfhi((unsigned)g[e]));
      *(i32x4*)d = o;
    }
    __syncthreads();
  }
}

DI void phase_outproj(const Params& P, char* shm) {
  constexpr int TILE_A = 32768, STAGE = 49152, NS = 96;
  const u16* hb = (const u16*)(P.ws + OFF_HB);
  const u16* W = (const u16*)(P.ws + OFF_W);
  u16* merged = (u16*)(P.ws + OFF_MERGED);
  const int tid = tid_(), lane = tid & 63, wid = tid >> 6, wr = wid >> 2, wc = wid & 3, fr = lane & 15, fq = lane >> 4;
  int sR0, sC0;
  stage_rc<2>(wid * 1024 + lane * 16, sR0, sC0);
  const int p1024 = sR0 * 1024 + sC0, p512 = sR0 * 512 + sC0;
  const int a_off = lds_byte<2>(fr, fq * 8) + wr * (8 * 2048);
  const int b_off = lds_byte<2>(fr, fq * 8) + wc * (2 * 2048);
  for (int tl = blockIdx.x; tl < 128 * 8; tl += gridDim.x) {
    int pm, pn;
    tile_map(tl, 128, 8, pm, pn);
    const int brow = pm * 256, bcol = pn * 128;
    f32x4 sum[8][2], acc[8][2];
    unsigned gq[8][2];
#pragma unroll
    for (int m = 0; m < 8; ++m)
#pragma unroll
      for (int n = 0; n < 2; ++n) {
        sum[m][n] = f32x4{0.f, 0.f, 0.f, 0.f};
      }
#define O_ISSUE(xs, rs_, buf)                                                                              \
  do {                                                                                                     \
    const bool gate_ = (rs_) < 16;                                                                         \
    const u16* Ab_ = gate_ ? hb + (size_t)brow * DM                                                        \
                           : (const u16*)(P.ws + OFF_ACTA + (size_t)(xs) * 32 * MiB) + (size_t)brow * 512; \
    const u16* Bb_ = gate_ ? W + W_IN + (size_t)(WR_GATE + (xs) * 1024 + bcol) * DM                        \
                           : W + W_A + (size_t)(xs) * 524288 + (size_t)bcol * 512;                         \
    const int ld_ = gate_ ? 1024 : 512, p0_ = gate_ ? p1024 : p512, kt_ = gate_ ? (rs_) : (rs_) - 16;      \
    _Pragma("unroll") for (int i = 0; i < 4; ++i) __builtin_amdgcn_global_load_lds(                        \
        (const unsigned*)(Ab_ + (p0_ + i * 64 * ld_ + kt_ * 64)),                                          \
        (unsigned*)(shm + (buf) * STAGE + wid * 1024 + i * 8192), 16, 0, 0);                               \
    _Pragma("unroll") for (int i = 0; i < 2; ++i) __builtin_amdgcn_global_load_lds(                        \
        (const unsigned*)(Bb_ + (p0_ + i * 64 * ld_ + kt_ * 64)),                                          \
        (unsigned*)(shm + (buf) * STAGE + TILE_A + wid * 1024 + i * 8192), 16, 0, 0);                      \
  } while (0)
    O_ISSUE(0, 0, 0);
    O_ISSUE(0, 1, 1);
    asm volatile("s_waitcnt vmcnt(6)" ::: "memory");
    asm volatile("s_waitcnt lgkmcnt(0)" ::: "memory");
    __builtin_amdgcn_s_barrier();
    int cur = 0, nxt = 2;
#define O_COMPUTE()                                                                                        \
  do {                                                                                                     \
    const char* sA = shm + cur * STAGE;                                                                    \
    const char* sB = sA + TILE_A;                                                                          \
    _Pragma("unroll") for (int ks = 0; ks < 2; ++ks) {                                                     \
      bf16x8 Bf[2], A0[4], A1[4];                                                                          \
      _Pragma("unroll") for (int n = 0; n < 2; ++n) Bf[n] = *(const bf16x8*)(sB + b_off + n * 2048 + ks * 1024); \
      _Pragma("unroll") for (int m = 0; m < 4; ++m) A0[m] = *(const bf16x8*)(sA + a_off + m * 2048 + ks * 1024); \
      _Pragma("unroll") for (int m = 0; m < 4; ++m) A1[m] = *(const bf16x8*)(sA + a_off + (4 + m) * 2048 + ks * 1024); \
      _Pragma("unroll") for (int m = 0; m < 4; ++m) _Pragma("unroll") for (int n = 0; n < 2; ++n)          \
          acc[m][n] = MFMA16(Bf[n], A0[m], acc[m][n]);                                                     \
      _Pragma("unroll") for (int m = 0; m < 4; ++m) _Pragma("unroll") for (int n = 0; n < 2; ++n)          \
          acc[4 + m][n] = MFMA16(Bf[n], A1[m], acc[4 + m][n]);                                             \
                             \
      __builtin_amdgcn_sched_group_barrier(0x100, 6, 0);                                                   \
      _Pragma("unroll") for (int i = 0; i < 4; ++i) {                                                      \
        __builtin_amdgcn_sched_group_barrier(0x100, 1, 0);                                                 \
        __builtin_amdgcn_sched_group_barrier(0x008, 2, 0);                                                 \
      }                                                                                                    \
      __builtin_amdgcn_sched_group_barrier(0x008, 8, 0);                                                   \
      __builtin_amdgcn_sched_barrier(0);                                                                   \
    }                                                                                                      \
  } while (0)
#define O_ROTATE()                                                                                         \
  do {                                                                                                     \
    asm volatile("s_waitcnt lgkmcnt(0)" ::: "memory");                                                     \
    __builtin_amdgcn_s_barrier();                                                                          \
    cur = (cur == 2) ? 0 : cur + 1;                                                                        \
    nxt = (nxt == 2) ? 0 : nxt + 1;                                                                        \
  } while (0)
#pragma clang loop unroll(disable)
    for (int x = 0; x < 4; ++x) {
#pragma unroll
      for (int m = 0; m < 8; ++m) { acc[m][0] = f32x4{0.f, 0.f, 0.f, 0.f}; acc[m][1] = f32x4{0.f, 0.f, 0.f, 0.f}; }
#pragma clang loop unroll(disable)
      for (int r = 0; r < 16; ++r) {
        O_ISSUE(x, r + 2, nxt);
        O_COMPUTE();
        asm volatile("s_waitcnt vmcnt(6)" ::: "memory");
        O_ROTATE();
      }
#pragma unroll
      for (int m = 0; m < 8; ++m)
#pragma unroll
        for (int n = 0; n < 2; ++n) {
          unsigned q = 0u;
          q = __builtin_amdgcn_cvt_pk_u8_f32(sigmoidf_(acc[m][n][0]) * 255.f, 0, q);
          q = __builtin_amdgcn_cvt_pk_u8_f32(sigmoidf_(acc[m][n][1]) * 255.f, 1, q);
          q = __builtin_amdgcn_cvt_pk_u8_f32(sigmoidf_(acc[m][n][2]) * 255.f, 2, q);
          q = __builtin_amdgcn_cvt_pk_u8_f32(sigmoidf_(acc[m][n][3]) * 255.f, 3, q);
          gq[m][n] = q;
          acc[m][n] = f32x4{0.f, 0.f, 0.f, 0.f};
        }
#pragma clang loop unroll(disable)
      for (int q = 0; q < 8; ++q) {
        const bool more = (q < 6) || (x < 3);
        if (q < 6) O_ISSUE(x, 18 + q, nxt);
        else if (x < 3) O_ISSUE(x + 1, q - 6, nxt);
        O_COMPUTE();
        if (more) asm volatile("s_waitcnt vmcnt(6)" ::: "memory");
        else asm volatile("s_waitcnt vmcnt(0)" ::: "memory");
        O_ROTATE();
      }
#pragma unroll
      for (int m = 0; m < 8; ++m)
#pragma unroll
        for (int n = 0; n < 2; ++n) {
          const unsigned q = gq[m][n];
          sum[m][n][0] += ((float)(q & 0xffu) * (1.f / 255.f)) * acc[m][n][0];
          sum[m][n][1] += ((float)((q >> 8) & 0xffu) * (1.f / 255.f)) * acc[m][n][1];
          sum[m][n][2] += ((float)((q >> 16) & 0xffu) * (1.f / 255.f)) * acc[m][n][2];
          sum[m][n][3] += ((float)(q >> 24) * (1.f / 255.f)) * acc[m][n][3];
        }
    }
#undef O_COMPUTE
#undef O_ROTATE
#undef O_ISSUE
#pragma unroll
    for (int m = 0; m < 8; ++m)
#pragma unroll
      for (int n = 0; n < 2; ++n) {
        const int row = wr * 128 + m * 16 + fr, col = wc * 32 + n * 16 + fq * 4;
        u32x2 o = {pack2(sum[m][n][0], sum[m][n][1]), pack2(sum[m][n][2], sum[m][n][3])};
        *(u32x2*)(shm + row * 272 + col * 2) = o;
      }
    __syncthreads();
#pragma unroll
    for (int i = 0; i < 8; ++i) {
      const int chunk = tid_() + i * 512, row = chunk >> 4, c8 = (chunk & 15) * 8;
      const i32x4 v = *(const i32x4*)(shm + row * 272 + c8 * 2);
      *(i32x4*)(merged + (size_t)(brow + row) * DM + bcol + c8) = v;
    }
    __syncthreads();
  }
}

DI void phase_wo(const Params& P, const float* xin, char* shm) {
  const u16* merged = (const u16*)(P.ws + OFF_MERGED);
  const u16* W = (const u16*)(P.ws + OFF_W) + W_O;
  const int tid = tid_(), lane = tid & 63, wid = tid >> 6, wr = wid >> 2, wc = wid & 3, fr = lane & 15, fq = lane >> 4;
  for (int tl = blockIdx.x; tl < 128 * 4; tl += gridDim.x) {
    int pm, pn;
    tile_map(tl, 128, 4, pm, pn);
    const int brow = pm * 256, bcol = pn * 256;
    f32x4 acc[8][4];
    gemm_main<8, 4>(acc, merged + (size_t)brow * DM, DM, W + (size_t)bcol * DM, DM, DM, shm);
#pragma unroll
    for (int ps = 0; ps < 2; ++ps) {
      if (wr == ps) {
#pragma unroll
        for (int m = 0; m < 8; ++m)
#pragma unroll
          for (int n = 0; n < 4; ++n) {
            const int row = m * 16 + fr, col = wc * 64 + n * 16 + fq * 4;
            *(f32x4*)(shm + row * 1040 + col * 4) = acc[m][n];
          }
      }
      __syncthreads();
#pragma unroll 4
      for (int i = 0; i < 16; ++i) {
        const int chunk = tid_() + i * 512, row = chunk >> 6, c4 = (chunk & 63) * 4;
        const f32x4 v = *(const f32x4*)(shm + row * 1040 + c4 * 4);
        const size_t off = (size_t)(brow + ps * 128 + row) * DM + bcol + c4;
        const f32x4 xv = *(const f32x4*)(xin + off);
        *(f32x4*)(P.out + off) = xv + v;
      }
      __syncthreads();
    }
  }
}

DI void phase_ple(const Params& P, char* shm) {
  const u16* hb = (const u16*)(P.ws + OFF_HB);
  const u16* pb = (const u16*)(P.ws + OFF_PB);
  const u16* W = (const u16*)(P.ws + OFF_W);
  const int tid = tid_(), lane = tid & 63, wid = tid >> 6, wr = wid >> 2, wc = wid & 3, fr = lane & 15, fq = lane >> 4;
  for (int tl = blockIdx.x; tl < 128 * 8; tl += gridDim.x) {
    int pm, pn;
    tile_map(tl, 128, 8, pm, pn);
    const int brow = pm * 256, bcol = pn * 128;
    f32x4 e[8][2], acc[8][2];
    gemm_main<8, 2>(e, pb + (size_t)brow * 256, 256, W + W_PLE + (size_t)bcol * 256, 256, 256, shm);
    gemm_main<8, 2>(acc, hb + (size_t)brow * DM, DM, W + W_G + (size_t)bcol * DM, DM, DM, shm);
#pragma unroll
    for (int m = 0; m < 8; ++m)
#pragma unroll
      for (int n = 0; n < 2; ++n) {
        const int row = wr * 128 + m * 16 + fr, col = wc * 32 + n * 16 + fq * 4;
        f32x4 v;
#pragma unroll
        for (int j = 0; j < 4; ++j) v[j] = sigmoidf_(acc[m][n][j]) * e[m][n][j];
        *(f32x4*)(shm + row * 528 + col * 4) = v;
      }
    __syncthreads();
#pragma unroll 4
    for (int i = 0; i < 16; ++i) {
      const int chunk = tid_() + i * 512, row = chunk >> 5, c4 = (chunk & 31) * 4;
      const f32x4 v = *(const f32x4*)(shm + row * 528 + c4 * 4);
      float* d = P.out + (size_t)(brow + row) * DM + bcol + c4;
      *(f32x4*)d = *(const f32x4*)d + v;
    }
    __syncthreads();
  }
}

DI void gbar(char* ws, int idx) {
  unsigned* cnt = (unsigned*)(ws + OFF_BAR) + idx * 64;
  asm volatile("s_waitcnt vmcnt(0)" ::: "memory");
  __syncthreads();
  if (threadIdx.x == 0) {
    __builtin_amdgcn_fence(__ATOMIC_RELEASE, "agent");
    asm volatile("s_waitcnt vmcnt(0)" ::: "memory");
    __hip_atomic_fetch_add(cnt, 1u, __ATOMIC_RELAXED, __HIP_MEMORY_SCOPE_AGENT);
    while (__hip_atomic_load(cnt, __ATOMIC_RELAXED, __HIP_MEMORY_SCOPE_AGENT) < gridDim.x) __builtin_amdgcn_s_sleep(1);
    __builtin_amdgcn_fence(__ATOMIC_ACQUIRE, "agent");
    asm volatile("s_waitcnt vmcnt(0)" ::: "memory");
  }
  __syncthreads();
}
DI unsigned xb_ld(unsigned* p) { return __hip_atomic_load(p, __ATOMIC_RELAXED, __HIP_MEMORY_SCOPE_AGENT); }
DI unsigned xb_add(unsigned* p, unsigned v) { return __hip_atomic_fetch_add(p, v, __ATOMIC_RELAXED, __HIP_MEMORY_SCOPE_AGENT); }
DI void xbar(char* ws, unsigned gen, unsigned xcc, unsigned nloc, unsigned nx) {
  unsigned* bar = (unsigned*)(ws + OFF_BAR);
  asm volatile("s_waitcnt vmcnt(0)" ::: "memory");
  __syncthreads();
  if (threadIdx.x == 0) {
    const unsigned old = xb_add(&bar[5120 + 64 * xcc], 1u);
    if (old == gen * nloc - 1u) {
      __builtin_amdgcn_fence(__ATOMIC_RELEASE, "agent");
      asm volatile("s_waitcnt vmcnt(0)" ::: "memory");
      const unsigned t = xb_add(&bar[7168], 1u);
      if (t == gen * nx - 1u) __hip_atomic_store(&bar[7232], gen, __ATOMIC_RELAXED, __HIP_MEMORY_SCOPE_AGENT);
      else while (xb_ld(&bar[7232]) < gen) __builtin_amdgcn_s_sleep(1);
      __hip_atomic_store(&bar[6144 + 64 * xcc], gen, __ATOMIC_RELAXED, __HIP_MEMORY_SCOPE_AGENT);
    } else {
      while (xb_ld(&bar[6144 + 64 * xcc]) < gen) __builtin_amdgcn_s_sleep(1);
    }
    __builtin_amdgcn_fence(__ATOMIC_ACQUIRE, "agent");
    asm volatile("s_waitcnt vmcnt(0)" ::: "memory");
  }
  __syncthreads();
}

#ifndef PROBE
#define PROBE 0
#endif
#define PH(...)                                                     \
  {                                                                 \
    Params Q = P;                                                   \
    asm volatile("" : "+s"(Q.ws), "+s"(Q.out), "+s"(Q.x));        \
    __VA_ARGS__;                                                    \
  }
__global__ void __launch_bounds__(512) fwd_megakernel(Params P) {
  __shared__ __attribute__((aligned(1024))) char shm[148480];
  cg::grid_group grid = cg::this_grid();
  const unsigned xcc = (unsigned)__builtin_amdgcn_s_getreg((3 << 11) | 20) & 0xFu;
  if (threadIdx.x == 0) xb_add((unsigned*)(P.ws + OFF_BAR) + 4096 + 64 * xcc, 1u);
  gbar(P.ws, 63);
  unsigned nloc = 0, nx = 0, bgen = 0;
  {
    unsigned* bar = (unsigned*)(P.ws + OFF_BAR);
    nloc = xb_ld(&bar[4096 + 64 * xcc]);
#pragma unroll
    for (int j = 0; j < 16; ++j) nx += (xb_ld(&bar[4096 + 64 * j]) != 0u) ? 1u : 0u;
  }
#define GSYNC(k) xbar(P.ws, ++bgen, xcc, nloc, nx)
  if (P.ws == nullptr) grid.sync();
#pragma clang loop unroll(disable)
  for (int l = 0; l < 2; ++l) {
#if PROBE == 7
    PH(phase_prep(Q, l, shm));
    PH(phase_rope(Q));
    PH(phase_norm(l == 0 ? Q.x : Q.out, (u16*)(Q.ws + OFF_HB)));
    GSYNC(0);
#endif
#if PROBE == 10
    for (int r = 0; r < 10; ++r) GSYNC(1);
#endif
    PH(phase_prep(Q, l, shm));
    if (l == 0) PH(phase_rope(Q));
    PH(phase_norm(l == 0 ? Q.x : Q.out, (u16*)(Q.ws + OFF_HB)));
    GSYNC(2);
#if PROBE == 3
    PH(phase_inproj<0>(Q, shm));
    PH(phase_inproj<1>(Q, shm));
    GSYNC(3);
#endif
    PH(phase_inproj<0>(Q, shm));
    PH(phase_inproj<1>(Q, shm));
    GSYNC(4);
    PH(phase_attn_d(Q, shm));
    PH(phase_mla_up(Q, l, shm));
    GSYNC(5);
#if PROBE == 8
    { int dry = 1; asm volatile("" : "+s"(dry)); PH(phase_kprep(Q, l, dry)); GSYNC(6); }
#endif
#if PROBE == 11
    { int dry = 1; asm volatile("" : "+s"(dry)); PH(phase_attn_d(Q, shm, dry)); GSYNC(7); }
#endif
#if PROBE == 1
    { int dry = 1; asm volatile("" : "+s"(dry)); PH(phase_attn_c(Q, l, shm, dry)); GSYNC(9); }
#endif
    PH(phase_attn_c(Q, l, shm, 0));
#if PROBE == 3
    PH(phase_inproj<2>(Q, shm));
    PH(phase_inproj<3>(Q, shm));
    GSYNC(11);
#endif
    PH(phase_inproj<2>(Q, shm));
    PH(phase_inproj<3>(Q, shm));
    GSYNC(12);
#if PROBE == 9
    { int dry = 1; asm volatile("" : "+s"(dry)); PH(phase_sgu(Q, l, shm, dry)); GSYNC(13); }
#endif
#if PROBE == 12
    PH(phase_pooled(Q)); GSYNC(14);
#endif
    PH(phase_sgu(Q, l, shm));
    PH(phase_pooled(Q));
    GSYNC(15);
    PH(phase_pool_gemm(Q, shm));
    GSYNC(16);
#if PROBE == 2
    PH(phase_outproj(Q, shm));
    GSYNC(17);
#endif
    PH(phase_outproj(Q, shm));
    GSYNC(18);
    PH(phase_wo(Q, l == 0 ? Q.x : Q.out, shm));
    GSYNC(19);
    PH(phase_norm(Q.out, (u16*)(Q.ws + OFF_HB)));
    GSYNC(20);
    PH(phase_ple(Q, shm));
    GSYNC(21);
  }
}

extern "C" void kernel_launch(void* const* d_in, const int* in_sizes, int n_in, void* d_out, int out_size,
                              void* d_ws, size_t ws_size, hipStream_t stream) {
  static int grid_blocks = 0;
  if (!grid_blocks) {
    int dev = 0, cus = 0, per_cu = 0;
    hipGetDevice(&dev);
    hipDeviceGetAttribute(&cus, hipDeviceAttributeMultiprocessorCount, dev);
    hipOccupancyMaxActiveBlocksPerMultiprocessor(&per_cu, fwd_megakernel, 512, 0);
    if (per_cu < 1) per_cu = 1;
    grid_blocks = cus * per_cu;
    if (grid_blocks > 256) grid_blocks = 256;
    grid_blocks &= ~7;
  }
  Params P{};
  P.x = (const float*)d_in[0]; P.p = (const float*)d_in[1]; P.pos = (const int*)d_in[2];
  P.norm_g = (const float*)d_in[3]; P.w_in = (const float*)d_in[4]; P.ln_v_g = (const float*)d_in[5];
  P.ln_v_b = (const float*)d_in[6]; P.sgu_w = (const float*)d_in[7]; P.sgu_b = (const float*)d_in[8];
  P.w_a_out = (const float*)d_in[9]; P.pool_w = (const float*)d_in[10]; P.pool_scale = (const float*)d_in[11];
  P.w_b_out = (const float*)d_in[12]; P.cq_norm_g = (const float*)d_in[13]; P.w_uq = (const float*)d_in[14];
  P.ckv_norm_g = (const float*)d_in[15]; P.w_ukv = (const float*)d_in[16]; P.q_norm_g = (const float*)d_in[17];
  P.k_norm_g = (const float*)d_in[18]; P.w_c_out = (const float*)d_in[19]; P.w_d_out = (const float*)d_in[20];
  P.w_o = (const float*)d_in[21]; P.w_ple = (const float*)d_in[22]; P.ple_norm_g = (const float*)d_in[23];
  P.w_ple_gate = (const float*)d_in[24];
  P.out = (float*)d_out; P.ws = (char*)d_ws;
  hipMemsetAsync((char*)d_ws + OFF_BAR, 0, 32768, stream);
  void* args[] = {&P};
  hipError_t e = hipLaunchCooperativeKernel((void*)fwd_megakernel, dim3(grid_blocks), dim3(512), args, 0, stream);
  if (e != hipSuccess) fprintf(stderr, "cooperative launch failed: %s (grid %d)\n", hipGetErrorString(e), grid_blocks);
}
```

```cpp
#include <hip/hip_runtime.h>
#include <hip/hip_cooperative_groups.h>
#include <cstdio>
namespace cg = cooperative_groups;

typedef unsigned short u16;
using bf16x8 = __attribute__((ext_vector_type(8))) short;
using f32x4 = __attribute__((ext_vector_type(4))) float;
using i32x4 = __attribute__((ext_vector_type(4))) int;
using u32x2 = __attribute__((ext_vector_type(2))) unsigned;
typedef __bf16 bf16x2_t __attribute__((ext_vector_type(2)));
typedef float f32x2_t __attribute__((ext_vector_type(2)));
#define DI __device__ __forceinline__
#define CBAR() asm volatile("" ::: "memory")
#define MFMA16(a, b, c) __builtin_amdgcn_mfma_f32_16x16x32_bf16((a), (b), (c), 0, 0, 0)

constexpr int T_TOK = 32768, SEQ = 8192, DM = 1024;
constexpr float EPS = 1e-6f;
constexpr size_t MiB = 1u << 20;
constexpr size_t OFF_W = 0, OFF_PB = 32 * MiB, OFF_HB = 48 * MiB, OFF_ACTA = 112 * MiB, OFF_ACTB = 144 * MiB,
                 OFF_ACTC = 176 * MiB, OFF_ACTD = 208 * MiB, OFF_PROJC = 240 * MiB, OFF_QRAW = 272 * MiB,
                 OFF_KC = 320 * MiB, OFF_VTC = 368 * MiB, OFF_PROJD = 400 * MiB, OFF_VTD = 464 * MiB,
                 OFF_ROPE = 496 * MiB, OFF_BAR = 504 * MiB, OFF_PROJA = 400 * MiB, OFF_PROJB = 464 * MiB, OFF_POOLED = 240 * MiB, OFF_MERGED = 272 * MiB;
constexpr size_t W_IN = 0, W_A = 9961472, W_B = W_A + 524288, W_C = W_B + 524288, W_D = W_C + 524288,
                 W_O = W_D + 524288, W_PLE = W_O + 1048576, W_G = W_PLE + 262144, W_UQ = W_G + 1048576,
                 W_UKV = W_UQ + 196608, W_POOL = W_UKV + 131072, W_SGU = W_POOL + 262144;
constexpr int WR_A = 0, WR_B = 1536, WR_C = 2560, WR_D = 3584, WR_GATE = 5632;

struct Params {
  const float* x; const float* p; const int* pos;
  const float *norm_g, *w_in, *ln_v_g, *ln_v_b, *sgu_w, *sgu_b, *w_a_out, *pool_w, *pool_scale, *w_b_out,
      *cq_norm_g, *w_uq, *ckv_norm_g, *w_ukv, *q_norm_g, *k_norm_g, *w_c_out, *w_d_out, *w_o, *w_ple,
      *ple_norm_g, *w_ple_gate;
  float* out; char* ws;
};

DI unsigned pack2(float a, float b) {
  f32x2_t v = {a, b};
  bf16x2_t r = __builtin_convertvector(v, bf16x2_t);
  return __builtin_bit_cast(unsigned, r);
}
DI u16 f2bf(float a) { return (u16)(pack2(a, 0.f) & 0xffffu); }
DI float bf2f(u16 v) { return __uint_as_float(((unsigned)v) << 16); }
DI float bflo(unsigned v) { return __uint_as_float(v << 16); }
DI float bfhi(unsigned v) { return __uint_as_float(v & 0xffff0000u); }
DI float sigmoidf_(float x) { return __builtin_amdgcn_rcpf(1.f + __expf(-x)); }
DI float siluf_(float x) { return x * __builtin_amdgcn_rcpf(1.f + __expf(-x)); }

template <int KS> DI int lds_byte(int r, int c) {
  int st = (r >> 4) * KS + (c >> 5), ob = (r & 15) * 64 + (c & 31) * 2;
  return st * 1024 + (ob ^ (((ob >> 9) & 1) << 5));
}
template <int KS> DI void stage_rc(int b, int& R, int& C) {
  int st = b >> 10, sb = b & 1023, swz = sb ^ (((sb >> 9) & 1) << 5);
  R = (st / KS) * 16 + swz / 64;
  C = (st % KS) * 32 + (swz % 64) / 2;
}

DI int tid_() { int t = threadIdx.x; asm volatile("" : "+v"(t)); return t; }
DI void tile_map(int wgid, int nM, int nN, int& pm, int& pn) {
  const int nwg = nM * nN, q = nwg / 8, r = nwg % 8, xcd = wgid % 8, off = wgid / 8;
  int w2 = (xcd < r ? xcd * (q + 1) : r * (q + 1) + (xcd - r) * q) + off;
  const int WGM = 8;
  int nig = WGM * nN, gid = w2 / nig, fm = gid * WGM, gsz = min(nM - fm, WGM);
  pm = fm + ((w2 % nig) % gsz);
  pn = (w2 % nig) / gsz;
}

template <int MF, int NF, bool SWAP = true>
DI void gemm_main(f32x4 (&acc)[MF][NF], const u16* __restrict__ Ab, int lda, const u16* __restrict__ Bb, int ldb,
                  int K, char* shm) {
  constexpr bool RING3 = (NF == 2);
  constexpr int TILE_A = 32768, STAGE = RING3 ? 49152 : 65536;
  const int tid = tid_(), wid = tid >> 6, lane = tid & 63, wr = wid >> 2, wc = wid & 3, fr = lane & 15,
            fq = lane >> 4;
  constexpr int AL = MF / 2;
  int sR0, sC0;
  stage_rc<2>(wid * 1024 + lane * 16, sR0, sC0);
#pragma unroll
  for (int m = 0; m < MF; ++m)
#pragma unroll
    for (int n = 0; n < NF; ++n) acc[m][n] = f32x4{0.f, 0.f, 0.f, 0.f};
  const int nt = K >> 6;
  const int pa0 = sR0 * lda + sC0, pb0 = sR0 * ldb + sC0;
#define G_STAGE(buf, kt)                                                                                \
  do {                                                                                                  \
    _Pragma("unroll") for (int i = 0; i < AL; ++i) __builtin_amdgcn_global_load_lds(                    \
        (const unsigned*)(Ab + (pa0 + i * 64 * lda + (kt) * 64)), (unsigned*)(shm + (buf) * STAGE + wid * 1024 + i * 8192), 16, 0, 0); \
    _Pragma("unroll") for (int i = 0; i < NF; ++i) __builtin_amdgcn_global_load_lds(                    \
        (const unsigned*)(Bb + (pb0 + i * 64 * ldb + (kt) * 64)), (unsigned*)(shm + (buf) * STAGE + TILE_A + wid * 1024 + i * 8192), 16, 0, 0); \
  } while (0)
  const int a_off = lds_byte<2>(fr, fq * 8) + wr * (MF * 2048);
  const int b_off = lds_byte<2>(fr, fq * 8) + wc * (NF * 2048);
  G_STAGE(0, 0);
  if constexpr (RING3) {
    if (nt > 1) { G_STAGE(1, 1); asm volatile("s_waitcnt vmcnt(6)" ::: "memory"); }
    else asm volatile("s_waitcnt vmcnt(0)" ::: "memory");
    asm volatile("s_waitcnt lgkmcnt(0)" ::: "memory");
    __builtin_amdgcn_s_barrier();
  } else {
    asm volatile("s_waitcnt vmcnt(0)" ::: "memory");
    __syncthreads();
  }
  int cur3 = 0, nxt3 = 2;
#pragma clang loop unroll(disable)
  for (int t = 0; t < nt; ++t) {
    const int cur = RING3 ? cur3 : (t & 1);
    if constexpr (RING3) {
      if (t + 2 < nt) G_STAGE(nxt3, t + 2);
    } else {
      if (t + 1 < nt) G_STAGE(cur ^ 1, t + 1);
    }
    const char* sA = shm + cur * STAGE;
    const char* sB = sA + TILE_A;
    if constexpr (MF == 8 && NF == 4) {
      bf16x8 B0[4], B1[4], A0[4], A1[4], A2[4], A3[4];
#define LDB_(dst, ks) _Pragma("unroll") for (int n = 0; n < 4; ++n) dst[n] = *(const bf16x8*)(sB + b_off + n * 2048 + (ks) * 1024)
#define LDA_(dst, ks, h) _Pragma("unroll") for (int m = 0; m < 4; ++m) dst[m] = *(const bf16x8*)(sA + a_off + ((h) * 4 + m) * 2048 + (ks) * 1024)
#define MMA_(A, B, h) _Pragma("unroll") for (int m = 0; m < 4; ++m) _Pragma("unroll") for (int n = 0; n < 4; ++n) \
      acc[(h) * 4 + m][n] = SWAP ? MFMA16(B[n], A[m], acc[(h) * 4 + m][n]) : MFMA16(A[m], B[n], acc[(h) * 4 + m][n])
      LDB_(B0, 0); LDA_(A0, 0, 0);
      LDA_(A1, 0, 1); MMA_(A0, B0, 0);
      LDB_(B1, 1); LDA_(A2, 1, 0); MMA_(A1, B0, 1);
      LDA_(A3, 1, 1); MMA_(A2, B1, 0);
      MMA_(A3, B1, 1);
#undef LDB_
#undef LDA_
#undef MMA_
      __builtin_amdgcn_sched_group_barrier(0x100, 8, 0);
#pragma unroll
      for (int i = 0; i < 4; ++i) { __builtin_amdgcn_sched_group_barrier(0x100, 1, 0); __builtin_amdgcn_sched_group_barrier(0x008, 4, 0); }
#pragma unroll
      for (int i = 0; i < 8; ++i) { __builtin_amdgcn_sched_group_barrier(0x100, 1, 0); __builtin_amdgcn_sched_group_barrier(0x008, 2, 0); }
#pragma unroll
      for (int i = 0; i < 4; ++i) { __builtin_amdgcn_sched_group_barrier(0x100, 1, 0); __builtin_amdgcn_sched_group_barrier(0x008, 4, 0); }
      __builtin_amdgcn_sched_group_barrier(0x008, 16, 0);
      __builtin_amdgcn_sched_barrier(0);
    } else {
#pragma unroll
    for (int ks = 0; ks < 2; ++ks) {
      bf16x8 Bf[NF];
#pragma unroll
      for (int n = 0; n < NF; ++n) Bf[n] = *(const bf16x8*)(sB + b_off + n * 2048 + ks * 1024);
      constexpr int MG = (NF == 2 && MF == 8) ? 4 : MF;
#pragma unroll
      for (int mg = 0; mg < MF / MG; ++mg) {
        bf16x8 At[MG];
#pragma unroll
        for (int m = 0; m < MG; ++m) At[m] = *(const bf16x8*)(sA + a_off + (mg * MG + m) * 2048 + ks * 1024);
#pragma unroll
        for (int m = 0; m < MG; ++m)
#pragma unroll
          for (int n = 0; n < NF; ++n)
            acc[mg * MG + m][n] = SWAP ? MFMA16(Bf[n], At[m], acc[mg * MG + m][n]) : MFMA16(At[m], Bf[n], acc[mg * MG + m][n]);
        if (mg == 0) __builtin_amdgcn_sched_group_barrier(0x100, MG + NF, 0);
        else __builtin_amdgcn_sched_group_barrier(0x100, MG, 0);
        __builtin_amdgcn_sched_group_barrier(0x008, MG * NF, 0);
        __builtin_amdgcn_sched_barrier(0);
      }
    }
    }
    if constexpr (RING3) {
      if (t + 2 < nt) asm volatile("s_waitcnt vmcnt(6)" ::: "memory");
      else asm volatile("s_waitcnt vmcnt(0)" ::: "memory");
      asm volatile("s_waitcnt lgkmcnt(0)" ::: "memory");
      __builtin_amdgcn_s_barrier();
      cur3 = (cur3 == 2) ? 0 : cur3 + 1;
      nxt3 = (nxt3 == 2) ? 0 : nxt3 + 1;
    } else {
      asm volatile("s_waitcnt vmcnt(0)" ::: "memory");
      __syncthreads();
    }
  }
#undef G_STAGE
}

DI void rowscale_prologue(const u16* Ab, int lda, int K, float* rs) {
  const int tid = tid_(), row = tid >> 1, half = tid & 1;
  const u16* p = Ab + (long)row * lda + half * (K >> 1);
  float ss = 0.f;
  for (int i = 0; i < (K >> 4); ++i) {
    i32x4 v = *(const i32x4*)(p + i * 8);
#pragma unroll
    for (int e = 0; e < 4; ++e) {
      float a = bflo((unsigned)v[e]), b = bfhi((unsigned)v[e]);
      ss += a * a + b * b;
    }
  }
  ss += __shfl_xor(ss, 1);
  if (half == 0) rs[row] = rsqrtf(ss / (float)K + EPS);
  __syncthreads();
}

DI void vt_store(u16* VT, int h, int dv, int row0, f32x4 v) {
  const int b = row0 >> 13, s0 = row0 & 8191;
  const int m32 = s0 >> 5, half = (s0 >> 4) & 1, fq = (s0 >> 2) & 3;
  const int sp = m32 * 32 + fq * 8 + half * 4;
  u32x2 o = {pack2(v[0], v[1]), pack2(v[2], v[3])};
  *(u32x2*)(VT + ((long)((b * 4 + h) * 128 + dv)) * SEQ + sp) = o;
}

struct TJob { const float* src; int ld, K, N, Npad; u16* dst; const float* rs; };
DI TJob get_job(const Params& P, int l, int j, u16* W) {
  TJob t;
  switch (j) {
    case 0: t = TJob{P.w_in + (size_t)l * 1024 * 9664, 9664, 1024, 3008, 3072, W + W_IN, P.norm_g + l * 1024}; break;
    case 1: t = TJob{P.w_in + (size_t)l * 1024 * 9664 + 3008, 9664, 1024, 6656, 6656, W + W_IN + (size_t)3072 * 1024, P.norm_g + l * 1024}; break;
    case 2: t = TJob{P.w_a_out + (size_t)l * 512 * 1024, 1024, 512, 1024, 1024, W + W_A, nullptr}; break;
    case 3: t = TJob{P.w_b_out + (size_t)l * 512 * 1024, 1024, 512, 1024, 1024, W + W_B, nullptr}; break;
    case 4: t = TJob{P.w_c_out + (size_t)l * 512 * 1024, 1024, 512, 1024, 1024, W + W_C, nullptr}; break;
    case 5: t = TJob{P.w_d_out + (size_t)l * 512 * 1024, 1024, 512, 1024, 1024, W + W_D, nullptr}; break;
    case 6: t = TJob{P.w_o + (size_t)l * 1024 * 1024, 1024, 1024, 1024, 1024, W + W_O, nullptr}; break;
    case 7: t = TJob{P.w_ple + (size_t)l * 256 * 1024, 1024, 256, 1024, 1024, W + W_PLE, nullptr}; break;
    case 8: t = TJob{P.w_ple_gate + (size_t)l * 1024 * 1024, 1024, 1024, 1024, 1024, W + W_G, P.ple_norm_g + l * 1024}; break;
    case 9: t = TJob{P.w_uq + (size_t)l * 256 * 768, 768, 256, 768, 768, W + W_UQ, P.cq_norm_g + l * 256}; break;
    default: t = TJob{P.w_ukv + (size_t)l * 128 * 1024, 1024, 128, 1024, 1024, W + W_UKV, P.ckv_norm_g + l * 128}; break;
  }
  return t;
}

DI void phase_prep(const Params& P, int l, char* shm) {
  u16* W = (u16*)(P.ws + OFF_W);
  float* tile = (float*)shm;
  const int tid = tid_();
  constexpr int NT0 = 16 * 48, NT1 = 16 * 104, NTA = 8 * 16, NTO = 16 * 16, NTP = 4 * 16, NTQ = 4 * 12, NTK = 2 * 16;
  constexpr int TOT = NT0 + NT1 + 4 * NTA + NTO + NTP + NTO + NTQ + NTK;
  for (int ft = blockIdx.x; ft < TOT; ft += gridDim.x) {
    int j, tl = ft;
    if (tl < NT0) j = 0;
    else if ((tl -= NT0) < NT1) j = 1;
    else if ((tl -= NT1) < 4 * NTA) { j = 2 + tl / NTA; tl %= NTA; }
    else if ((tl -= 4 * NTA) < NTO) j = 6;
    else if ((tl -= NTO) < NTP) j = 7;
    else if ((tl -= NTP) < NTO) j = 8;
    else if ((tl -= NTO) < NTQ) j = 9;
    else { tl -= NTQ; j = 10; }
    TJob J = get_job(P, l, j, W);
    const int nk = J.K >> 6;
    {
      const int tk = tl % nk, tn = tl / nk;
#pragma unroll
      for (int i = 0; i < 2; ++i) {
        int idx = tid + i * 512, kk = idx >> 4, n4 = (idx & 15) * 4;
        int n = tn * 64 + n4, k = tk * 64 + kk;
        float4 v = make_float4(0.f, 0.f, 0.f, 0.f);
        if (n < J.N) {
          v = *(const float4*)(J.src + (size_t)k * J.ld + n);
          if (J.rs) { float s = J.rs[k]; v.x *= s; v.y *= s; v.z *= s; v.w *= s; }
        }
        float* d = tile + kk * 65 + n4;
        d[0] = v.x; d[1] = v.y; d[2] = v.z; d[3] = v.w;
      }
      __syncthreads();
      {
        int nl = tid >> 3, k8 = (tid & 7) * 8;
        const float* s = tile + k8 * 65 + nl;
        i32x4 o;
        o[0] = (int)pack2(s[0], s[65]);
        o[1] = (int)pack2(s[130], s[195]);
        o[2] = (int)pack2(s[260], s[325]);
        o[3] = (int)pack2(s[390], s[455]);
        *(i32x4*)(J.dst + (size_t)(tn * 64 + nl) * J.K + tk * 64 + k8) = o;
      }
      __syncthreads();
    }
  }
  const int gtid = blockIdx.x * 512 + tid, gn = gridDim.x * 512;
  {
    const float* src = P.sgu_w + (size_t)l * 65536;
    u16* dst = W + W_SGU;
    for (int i = gtid; i < 65536; i += gn) {
      int s = i & 127, t = (i >> 7) & 127;
      dst[i] = ((s >> 6) <= (t >> 6)) ? f2bf(src[i]) : (u16)0;
    }
  }
  {
    const float* pw = P.pool_w + (size_t)l * 65536;
    const float* sc = P.pool_scale + l * 512;
    u16* dst = W + W_POOL;
    for (int i = gtid; i < 262144; i += gn) {
      int n = i >> 9, k = i & 511, g = n >> 7, d = n & 127, g2 = k >> 7, c = k & 127;
      dst[i] = (g == g2) ? f2bf(pw[(g * 128 + c) * 128 + d] * sc[n]) : (u16)0;
    }
  }
  {
    const float* src = P.p + (size_t)l * T_TOK * 256;
    u16* dst = (u16*)(P.ws + OFF_PB);
    for (int i = gtid; i < T_TOK * 256 / 8; i += gn) {
      float4 a = *(const float4*)(src + (size_t)i * 8), b = *(const float4*)(src + (size_t)i * 8 + 4);
      i32x4 o;
      o[0] = (int)pack2(a.x, a.y); o[1] = (int)pack2(a.z, a.w); o[2] = (int)pack2(b.x, b.y); o[3] = (int)pack2(b.z, b.w);
      *(i32x4*)(dst + (size_t)i * 8) = o;
    }
  }
}

DI void phase_rope(const Params& P) {
  float2* tab = (float2*)(P.ws + OFF_ROPE);
  const int gtid = blockIdx.x * 512 + tid_(), gn = gridDim.x * 512;
  for (int i = gtid; i < T_TOK * 32; i += gn) {
    const int t = i >> 5, f = i & 31;
    const float freq = exp2f(-(float)f * (13.287712379549449f / 32.f));
    const float ang = (float)P.pos[t] * freq;
    tab[i] = make_float2(cosf(ang), sinf(ang));
  }
}

DI void phase_norm(const float* xin, u16* hb) {
  const int lane = tid_() & 63, gw = blockIdx.x * 8 + (tid_() >> 6), nw = gridDim.x * 8;
  for (int t = gw; t < T_TOK; t += nw) {
    const float* r = xin + (size_t)t * DM;
    float4 v[4];
    float ss = 0.f;
#pragma unroll
    for (int i = 0; i < 4; ++i) {
      v[i] = *(const float4*)(r + i * 256 + lane * 4);
      ss += v[i].x * v[i].x + v[i].y * v[i].y + v[i].z * v[i].z + v[i].w * v[i].w;
    }
#pragma unroll
    for (int o = 32; o > 0; o >>= 1) ss += __shfl_xor(ss, o);
    const float rs = rsqrtf(ss * (1.f / DM) + EPS);
#pragma unroll
    for (int i = 0; i < 4; ++i) {
      u32x2 o = {pack2(v[i].x * rs, v[i].y * rs), pack2(v[i].z * rs, v[i].w * rs)};
      *(u32x2*)(hb + (size_t)t * DM + i * 256 + lane * 4) = o;
    }
  }
}

template <int MODE>
DI void phase_inproj(const Params& P, char* shm) {
  const u16* hb = (const u16*)(P.ws + OFF_HB);
  const u16* W = (const u16*)(P.ws + OFF_W) + W_IN;
  constexpr int wrow = MODE == 0 ? WR_C : MODE == 1 ? WR_D : MODE == 2 ? WR_A : WR_B;
  constexpr int nN = MODE == 0 ? 4 : MODE == 1 ? 8 : MODE == 2 ? 6 : 4;
  constexpr int SILU0 = MODE == 0 ? 512 : MODE == 1 ? 1536 : MODE == 2 ? 1024 : 512;
  const int tid = tid_(), lane = tid & 63, wid = tid >> 6, wr = wid >> 2, wc = wid & 3, fr = lane & 15, fq = lane >> 4;
  for (int tl = blockIdx.x; tl < 128 * nN; tl += gridDim.x) {
    int pm, pn;
    tile_map(tl, 128, nN, pm, pn);
    const int brow = pm * 256, bcol = pn * 256;
    f32x4 acc[8][4];
    const bool vt = (MODE == 1) && bcol >= 1024 && bcol < 1536;
    const bool silu = bcol >= SILU0;
    if (vt) {
      gemm_main<8, 4, false>(acc, hb + (size_t)brow * DM, DM, W + (size_t)(wrow + bcol) * DM, DM, DM, shm);
#pragma unroll
      for (int m = 0; m < 8; ++m)
#pragma unroll
        for (int n = 0; n < 4; ++n) {
          const int dv = wc * 64 + n * 16 + fr;
          const int p = (wr * 4 + (m >> 1)) * 32 + fq * 8 + (m & 1) * 4;
          u32x2 o = {pack2(acc[m][n][0], acc[m][n][1]), pack2(acc[m][n][2], acc[m][n][3])};
          *(u32x2*)(shm + dv * 528 + p * 2) = o;
        }
    } else {
      gemm_main<8, 4, true>(acc, hb + (size_t)brow * DM, DM, W + (size_t)(wrow + bcol) * DM, DM, DM, shm);
#pragma unroll
      for (int m = 0; m < 8; ++m)
#pragma unroll
        for (int n = 0; n < 4; ++n) {
          const int row = wr * 128 + m * 16 + fr, col = wc * 64 + n * 16 + fq * 4;
          f32x4 v = acc[m][n];
          if (silu) { v[0] = siluf_(v[0]); v[1] = siluf_(v[1]); v[2] = siluf_(v[2]); v[3] = siluf_(v[3]); }
          u32x2 o = {pack2(v[0], v[1]), pack2(v[2], v[3])};
          *(u32x2*)(shm + row * 528 + col * 2) = o;
        }
    }
    __syncthreads();
#pragma unroll 4
    for (int i = 0; i < 16; ++i) {
      const int chunk = tid_() + i * 512, row = chunk >> 5, c8 = (chunk & 31) * 8;
      const i32x4 v = *(const i32x4*)(shm + row * 528 + c8 * 2);
      const int gcol = bcol + c8;
      u16* d = nullptr;
      if (MODE == 0) {
        if (gcol < 448) d = (u16*)(P.ws + OFF_PROJC) + (size_t)(brow + row) * 448 + gcol;
        else if (gcol >= 512) d = (u16*)(P.ws + OFF_ACTC) + (size_t)(brow + row) * 512 + (gcol - 512);
      } else if (MODE == 1) {
        if (gcol < 1024) d = (u16*)(P.ws + OFF_PROJD) + (size_t)(brow + row) * 1024 + gcol;
        else if (gcol < 1536) {
          const int c2 = gcol - c8 - 1024 + row;
          const int b = brow >> 13, s0 = brow & 8191;
          d = (u16*)(P.ws + OFF_VTD) + ((size_t)((b * 4 + (c2 >> 7)) * 128 + (c2 & 127))) * SEQ + s0 + c8;
        } else d = (u16*)(P.ws + OFF_ACTD) + (size_t)(brow + row) * 512 + (gcol - 1536);
      } else if (MODE == 2) {
        if (gcol < 1024) d = (u16*)(P.ws + OFF_PROJA) + (size_t)(brow + row) * 1024 + gcol;
        else d = (u16*)(P.ws + OFF_ACTA) + (size_t)(brow + row) * 512 + (gcol - 1024);
      } else {
        if (gcol < 512) d = (u16*)(P.ws + OFF_PROJB) + (size_t)(brow + row) * 512 + gcol;
        else d = (u16*)(P.ws + OFF_ACTB) + (size_t)(brow + row) * 512 + (gcol - 512);
      }
      if (d) *(i32x4*)d = v;
    }
    __syncthreads();
  }
}

DI void phase_mla_up(const Params& P, int l, char* shm) {
  const u16* projC = (const u16*)(P.ws + OFF_PROJC);
  const float* kng = P.k_norm_g + l * 192;
  const u16* W = (const u16*)(P.ws + OFF_W);
  float* rs = (float*)(shm + 137216);
  const int tid = tid_(), lane = tid & 63, wid = tid >> 6, wr = wid >> 2, wc = wid & 3, fr = lane & 15, fq = lane >> 4;
  for (int tl = blockIdx.x; tl < 128 * 4; tl += gridDim.x) {
    int pm, pn;
    tile_map(tl, 128, 4, pm, pn);
    const int brow = pm * 256, bcol = pn * 256, h = pn;
    const u16* Ab = projC + (size_t)brow * 448 + 256;
    rowscale_prologue(Ab, 448, 128, rs);
    f32x4 acc[8][4];
    gemm_main<8, 4, false>(acc, Ab, 448, W + W_UKV + (size_t)bcol * 128, 128, 128, shm);
#pragma unroll
    for (int m = 0; m < 8; ++m) {
      const int rl = wr * 128 + m * 16 + fq * 4;
      const f32x4 sc = *(const f32x4*)(rs + rl);
#pragma unroll
      for (int n = 0; n < 4; ++n) {
        const f32x4 v = acc[m][n] * sc;
        if (wc < 2) {
          const int col = wc * 64 + n * 16 + fr;
#pragma unroll
          for (int j = 0; j < 4; ++j) *(u16*)(shm + (rl + j) * 272 + col * 2) = f2bf(v[j]);
        } else {
          const int dv = (wc - 2) * 64 + n * 16 + fr;
          const int p = (wr * 4 + (m >> 1)) * 32 + fq * 8 + (m & 1) * 4;
          u32x2 o = {pack2(v[0], v[1]), pack2(v[2], v[3])};
          *(u32x2*)(shm + 69632 + dv * 528 + p * 2) = o;
        }
      }
    }
    __syncthreads();
    {
      const int b = brow >> 13, s0 = brow & 8191;
#pragma unroll 2
      for (int i = 0; i < 8; ++i) {
        const int chunk = tid_() + i * 512, row = chunk >> 4, j16 = chunk & 15, c8 = j16 * 8, t = brow + row;
        const i32x4 v = *(const i32x4*)(shm + row * 272 + c8 * 2);
        const u32x2 krr = *(const u32x2*)(projC + (size_t)t * 448 + 384 + j16 * 4);
        float kv[8], kr[4];
#pragma unroll
        for (int e = 0; e < 4; ++e) { kv[2 * e] = bflo((unsigned)v[e]); kv[2 * e + 1] = bfhi((unsigned)v[e]); }
        kr[0] = bflo(krr[0]); kr[1] = bfhi(krr[0]); kr[2] = bflo(krr[1]); kr[3] = bfhi(krr[1]);
        float ss = 0.f;
#pragma unroll
        for (int e = 0; e < 8; ++e) ss += kv[e] * kv[e];
#pragma unroll
        for (int e = 0; e < 4; ++e) ss += kr[e] * kr[e];
        ss += __shfl_xor(ss, 1); ss += __shfl_xor(ss, 2); ss += __shfl_xor(ss, 4); ss += __shfl_xor(ss, 8);
        const float r = rsqrtf(ss * (1.f / 192.f) + EPS);
        u16* kd = (u16*)(P.ws + OFF_KC) + ((size_t)((b * 4 + h) * SEQ + s0 + row)) * 192;
        const f32x4 g0 = *(const f32x4*)(kng + c8), g1 = *(const f32x4*)(kng + c8 + 4);
        i32x4 o;
        o[0] = (int)pack2(kv[0] * r * g0[0], kv[1] * r * g0[1]);
        o[1] = (int)pack2(kv[2] * r * g0[2], kv[3] * r * g0[3]);
        o[2] = (int)pack2(kv[4] * r * g1[0], kv[5] * r * g1[1]);
        o[3] = (int)pack2(kv[6] * r * g1[2], kv[7] * r * g1[3]);
        *(i32x4*)(kd + c8) = o;
        const f32x4 gr = *(const f32x4*)(kng + 128 + j16 * 4);
        const f32x4* rt = (const f32x4*)(P.ws + OFF_ROPE) + (size_t)t * 16 + (j16 & 7) * 2;
        const f32x4 cs01 = rt[0], cs23 = rt[1];
        float my[4], ot[4], rv[4];
#pragma unroll
        for (int e = 0; e < 4; ++e) { my[e] = kr[e] * r * gr[e]; ot[e] = __shfl_xor(my[e], 8); }
        const float sgn = (j16 < 8) ? -1.f : 1.f;
        rv[0] = my[0] * cs01[0] + sgn * ot[0] * cs01[1];
        rv[1] = my[1] * cs01[2] + sgn * ot[1] * cs01[3];
        rv[2] = my[2] * cs23[0] + sgn * ot[2] * cs23[1];
        rv[3] = my[3] * cs23[2] + sgn * ot[3] * cs23[3];
        u32x2 ro = {pack2(rv[0], rv[1]), pack2(rv[2], rv[3])};
        *(u32x2*)(kd + 128 + j16 * 4) = ro;
      }
#pragma unroll 4
      for (int i = 0; i < 8; ++i) {
        const int chunk = tid_() + i * 512, dv = chunk >> 5, c8 = (chunk & 31) * 8;
        const i32x4 v = *(const i32x4*)(shm + 69632 + dv * 528 + c8 * 2);
        *(i32x4*)((u16*)(P.ws + OFF_VTC) + ((size_t)((b * 4 + h) * 128 + dv)) * SEQ + s0 + c8) = v;
      }
    }
    __syncthreads();
  }
  for (int tl = blockIdx.x; tl < 128 * 3; tl += gridDim.x) {
    int pm, pn;
    tile_map(tl, 128, 3, pm, pn);
    const int brow = pm * 256, bcol = pn * 256;
    const u16* Ab = projC + (size_t)brow * 448;
    rowscale_prologue(Ab, 448, 256, rs);
    f32x4 acc[8][4];
    gemm_main<8, 4>(acc, Ab, 448, W + W_UQ + (size_t)bcol * 256, 256, 256, shm);
#pragma unroll
    for (int m = 0; m < 8; ++m) {
      const int rl = wr * 128 + m * 16 + fr;
      const float sc = rs[rl];
#pragma unroll
      for (int n = 0; n < 4; ++n) {
        const int col = wc * 64 + n * 16 + fq * 4;
        const f32x4 v = acc[m][n] * sc;
        u32x2 o = {pack2(v[0], v[1]), pack2(v[2], v[3])};
        *(u32x2*)(shm + rl * 528 + col * 2) = o;
      }
    }
    __syncthreads();
#pragma unroll 4
    for (int i = 0; i < 16; ++i) {
      const int chunk = tid_() + i * 512, row = chunk >> 5, c8 = (chunk & 31) * 8;
      const i32x4 v = *(const i32x4*)(shm + row * 528 + c8 * 2);
      *(i32x4*)((u16*)(P.ws + OFF_QRAW) + (size_t)(brow + row) * 768 + bcol + c8) = v;
    }
    __syncthreads();
  }
}

DI void phase_kprep(const Params& P, int l, int dry = 0) {
  const int lane = tid_() & 63, gw = blockIdx.x * 8 + (tid_() >> 6), nw = gridDim.x * 8;
  const float* g = P.k_norm_g + l * 192;
  const u16* projC = (const u16*)(P.ws + OFF_PROJC);
  u16* Kc = (u16*)(P.ws + OFF_KC);
  const float g0 = g[2 * lane], g1 = g[2 * lane + 1];
  const float gr1 = g[128 + (lane & 31)], gr2 = g[160 + (lane & 31)];
  for (int it = gw; it < T_TOK * 4; it += nw) {
    const int t = it >> 2, h = it & 3, b = t >> 13, s = t & 8191;
    u16* kr = Kc + ((size_t)((b * 4 + h) * SEQ + s)) * 192;
    const unsigned kv = *(const unsigned*)(kr + 2 * lane);
    float v0 = bflo(kv), v1 = bfhi(kv);
    float r1 = 0.f, r2 = 0.f;
    if (lane < 32) {
      r1 = bf2f(projC[(size_t)t * 448 + 384 + lane]);
      r2 = bf2f(projC[(size_t)t * 448 + 416 + lane]);
    }
    float ss = v0 * v0 + v1 * v1 + r1 * r1 + r2 * r2;
#pragma unroll
    for (int o = 32; o > 0; o >>= 1) ss += __shfl_xor(ss, o);
    const float r = rsqrtf(ss * (1.f / 192.f) + EPS);
    if (!dry) *(unsigned*)(kr + 2 * lane) = pack2(v0 * r * g0, v1 * r * g1);
    if (lane < 32 && !dry) {
      const float2 cssn = ((const float2*)(P.ws + OFF_ROPE))[(size_t)t * 32 + lane];
      const float cs = cssn.x, sn = cssn.y;
      const float x1 = r1 * r * gr1, x2 = r2 * r * gr2;
      kr[128 + lane] = f2bf(x1 * cs - x2 * sn);
      kr[160 + lane] = f2bf(x2 * cs + x1 * sn);
    }
  }
}

DI void phase_attn_d(const Params& P, char* shm, int dry = 0) {
  constexpr int KT_B = 16384, VT_B = 16384, BUF_B = KT_B + VT_B;
  const int tid = tid_();
  const int wid = __builtin_amdgcn_readfirstlane(tid >> 6), lane = tid & 63, fr = lane & 15, fq = lane >> 4;
  const u16* projD = (const u16*)(P.ws + OFF_PROJD);
  const u16* VT = (const u16*)(P.ws + OFF_VTD);
  u16* actD = (u16*)(P.ws + OFF_ACTD);
  volatile int* sdone = (volatile int*)(shm + 2 * BUF_B);
  const float sc = 0.08838834764831845f;
  int kR[2], kC[2], vR[2], vC[2];
#pragma unroll
  for (int i = 0; i < 2; ++i) {
    stage_rc<4>((tid + i * 512) * 16, kR[i], kC[i]);
    stage_rc<2>((tid + i * 512) * 16, vR[i], vC[i]);
  }
  int pk[2], pv[2];
#pragma unroll
  for (int i = 0; i < 2; ++i) { pk[i] = kR[i] * 1024 + kC[i]; pv[i] = vR[i] * SEQ + vC[i]; }
  const int kf_off = lds_byte<4>(fr, fq * 8), vf_off = lds_byte<2>(fr, fq * 8);
  for (int it = blockIdx.x; it < 16 * 64; it += gridDim.x) {
    const int bh = it >> 6, qb = it & 63, b = bh >> 2, h = bh & 3, T0 = qb * 128, t0 = T0 + wid * 16;
    const u16* Kg = projD + (size_t)(b * SEQ) * 1024 + 512 + h * 128;
    const u16* Vg = VT + (size_t)(bh * 128) * SEQ;
#define D_STAGE(buf, kb_)                                                                                  \
  do {                                                                                                     \
    _Pragma("unroll") for (int i = 0; i < 2; ++i) __builtin_amdgcn_global_load_lds(                        \
        (const unsigned*)(Kg + (pk[i] + (kb_) * 1024)), (unsigned*)(shm + (buf) * BUF_B + wid * 1024 + i * 8192), 16, 0, 0); \
    _Pragma("unroll") for (int i = 0; i < 2; ++i) __builtin_amdgcn_global_load_lds(                        \
        (const unsigned*)(Vg + (pv[i] + (kb_))), (unsigned*)(shm + (buf) * BUF_B + KT_B + wid * 1024 + i * 8192), 16, 0, 0); \
  } while (0)
    const int kb_top = T0 + 64;
    D_STAGE(0, kb_top);
    const u16* qp = projD + (size_t)(b * SEQ + t0 + fr) * 1024 + h * 128 + fq * 8;
    bf16x8 qf[4];
#pragma unroll
    for (int ks = 0; ks < 4; ++ks) qf[ks] = *(const bf16x8*)(qp + ks * 32);
    f32x4 o[8];
#pragma unroll
    for (int i = 0; i < 8; ++i) o[i] = f32x4{0.f, 0.f, 0.f, 0.f};
    float R = 0.f;
    const int tq = t0 + fr;
    const int kbw = (t0 >> 6) << 6;
    int done = 0;
    asm volatile("s_waitcnt vmcnt(0)" ::: "memory");
    __syncthreads();
    int iter = 0;
#pragma clang loop unroll(disable)
    for (int kb = kb_top;; kb -= 64, ++iter) {
      const int cur = iter & 1;
      const bool more = kb >= 64;
      if (more) D_STAGE(cur ^ 1, kb - 64);
      if (!done && kb <= kbw) {
        const char* Kf = shm + cur * BUF_B + kf_off;
        const char* Vf = shm + cur * BUF_B + KT_B + vf_off;
        f32x4 z[4];
#pragma unroll
        for (int sub = 0; sub < 4; ++sub) {
          z[sub] = f32x4{0.f, 0.f, 0.f, 0.f};
#pragma unroll
          for (int ks = 0; ks < 4; ++ks) {
            const bf16x8 kf = *(const bf16x8*)(Kf + sub * 4096 + ks * 1024);
            z[sub] = MFMA16(kf, qf[ks], z[sub]);
          }
        }
        float lk[4][4], lz[4][4], loc[4];
#pragma unroll
        for (int sub = 0; sub < 4; ++sub) {
          loc[sub] = 0.f;
#pragma unroll
          for (int j = 0; j < 4; ++j) {
            const int key = kb + sub * 16 + fq * 4 + j;
            const bool valid = key < tq;
            const float zv = z[sub][j] * sc;
            const float sp = fmaxf(zv, 0.f) + __logf(1.f + __expf(-fabsf(zv)));
            lk[sub][j] = valid ? -sp : 0.f;
            lz[sub][j] = valid ? (zv - sp) : -1e30f;
            loc[sub] += lk[sub][j];
          }
        }
        float run = R;
        float a[4][4];
#pragma unroll
        for (int sub = 3; sub >= 0; --sub) {
          const float p = __shfl_xor(loc[sub], 16);
          const float pr = loc[sub] + p;
          const float c = __shfl_xor(pr, 32);
          const float suf_in = (fq == 3) ? 0.f : (fq == 2) ? p : (fq == 1) ? c : (p + c);
          float af = run + suf_in;
#pragma unroll
          for (int j = 3; j >= 0; --j) {
            a[sub][j] = __expf(lz[sub][j] + af);
            af += lk[sub][j];
          }
          run += pr + c;
        }
        R = run;
        bf16x8 pf[2];
#pragma unroll
        for (int kk = 0; kk < 2; ++kk) {
          i32x4 pkk;
          pkk[0] = (int)pack2(a[2 * kk][0], a[2 * kk][1]);
          pkk[1] = (int)pack2(a[2 * kk][2], a[2 * kk][3]);
          pkk[2] = (int)pack2(a[2 * kk + 1][0], a[2 * kk + 1][1]);
          pkk[3] = (int)pack2(a[2 * kk + 1][2], a[2 * kk + 1][3]);
          pf[kk] = __builtin_bit_cast(bf16x8, pkk);
        }
#pragma unroll
        for (int dvs = 0; dvs < 8; ++dvs) {
          const bf16x8 v0 = *(const bf16x8*)(Vf + dvs * 2048);
          const bf16x8 v1 = *(const bf16x8*)(Vf + dvs * 2048 + 1024);
          o[dvs] = MFMA16(v0, pf[0], o[dvs]);
          o[dvs] = MFMA16(v1, pf[1], o[dvs]);
        }
        if (__all(R < -104.f)) done = 1;
      }
      if (lane == 0) sdone[cur * 8 + wid] = done;
      asm volatile("s_waitcnt vmcnt(0)" ::: "memory");
      __syncthreads();
      int alld = 1;
#pragma unroll
      for (int w = 0; w < 8; ++w) alld &= sdone[cur * 8 + w];
      if (alld || !more) break;
    }
#undef D_STAGE
    u16* dp = actD + (size_t)(b * SEQ + t0 + fr) * 512 + h * 128 + fq * 4;
#pragma unroll
    for (int dvs = 0; dvs < 8; ++dvs) {
      u32x2 gz = *(const u32x2*)(dp + dvs * 16);
      u32x2 ov = {pack2(o[dvs][0] * bflo(gz[0]), o[dvs][1] * bfhi(gz[0])),
                  pack2(o[dvs][2] * bflo(gz[1]), o[dvs][3] * bfhi(gz[1]))};
      if (!dry) *(u32x2*)(dp + dvs * 16) = ov;
    }
    __syncthreads();
  }
}

DI void attn_c_item(const Params& P, int l, int b, int h, int qb, char* shm, float B2, int dry) {
  const int tid = tid_();
  const int wid = __builtin_amdgcn_readfirstlane(tid >> 6), lane = tid & 63, fr = lane & 15, fq = lane >> 4;
  const u16* Kg = (const u16*)(P.ws + OFF_KC) + (size_t)((b * 4 + h) * SEQ) * 192;
  const u16* Vg = (const u16*)(P.ws + OFF_VTC) + (size_t)((b * 4 + h) * 128) * SEQ;
  const u16* qraw = (const u16*)(P.ws + OFF_QRAW);
  const float* qg = P.q_norm_g + l * 192;
  const int q0 = qb * 256 + wid * 32;
  bf16x8 qf[2][6];
  const float qscale = 0.07216878364870323f * 1.4426950408889634f;
#pragma unroll
  for (int qs = 0; qs < 2; ++qs) {
    const int t = b * SEQ + q0 + qs * 16 + fr;
    const u16* qp = qraw + (size_t)t * 768 + h * 192 + fq * 8;
    float v[6][8];
    float ss = 0.f;
#pragma unroll
    for (int ks = 0; ks < 6; ++ks) {
      i32x4 raw = *(const i32x4*)(qp + ks * 32);
#pragma unroll
      for (int e = 0; e < 4; ++e) {
        v[ks][2 * e] = bflo((unsigned)raw[e]);
        v[ks][2 * e + 1] = bfhi((unsigned)raw[e]);
        ss += v[ks][2 * e] * v[ks][2 * e] + v[ks][2 * e + 1] * v[ks][2 * e + 1];
      }
    }
    ss += __shfl_xor(ss, 16);
    ss += __shfl_xor(ss, 32);
    const float r = rsqrtf(ss * (1.f / 192.f) + EPS);
#pragma unroll
    for (int ks = 0; ks < 6; ++ks)
#pragma unroll
      for (int e = 0; e < 8; ++e) v[ks][e] *= r * qg[ks * 32 + fq * 8 + e];
    const f32x4* rt = (const f32x4*)(P.ws + OFF_ROPE) + (size_t)t * 16 + fq * 4;
#pragma unroll
    for (int e2 = 0; e2 < 4; ++e2) {
      const f32x4 cssn = rt[e2];
#pragma unroll
      for (int u = 0; u < 2; ++u) {
        const int e = e2 * 2 + u;
        const float cs = cssn[2 * u], sn = cssn[2 * u + 1];
        const float x1 = v[4][e], x2 = v[5][e];
        v[4][e] = x1 * cs - x2 * sn;
        v[5][e] = x2 * cs + x1 * sn;
      }
    }
#pragma unroll
    for (int ks = 0; ks < 6; ++ks) {
      i32x4 pk;
#pragma unroll
      for (int e = 0; e < 4; ++e) pk[e] = (int)pack2(v[ks][2 * e] * qscale, v[ks][2 * e + 1] * qscale);
      qf[qs][ks] = __builtin_bit_cast(bf16x8, pk);
    }
  }
  constexpr int KT_B = 24576, VT_B = 16384, BUF_B = KT_B + VT_B;
  const int ntile = qb * 4 + 4;
  const int my_last = qb * 4 + (wid >> 1);
  f32x4 o[8][2];
#pragma unroll
  for (int i = 0; i < 8; ++i) { o[i][0] = f32x4{0.f, 0.f, 0.f, 0.f}; o[i][1] = f32x4{0.f, 0.f, 0.f, 0.f}; }
  float lsum[2] = {0.f, 0.f};
  int kR[3], kC[3], vR[2], vC[2];
#pragma unroll
  for (int i = 0; i < 3; ++i) stage_rc<6>((tid + i * 512) * 16, kR[i], kC[i]);
#pragma unroll
  for (int i = 0; i < 2; ++i) stage_rc<2>((tid + i * 512) * 16, vR[i], vC[i]);
  int pk[3], pv[2];
#pragma unroll
  for (int i = 0; i < 3; ++i) pk[i] = kR[i] * 192 + kC[i];
#pragma unroll
  for (int i = 0; i < 2; ++i) pv[i] = vR[i] * SEQ + vC[i];
#define A_STAGE(buf, kt)                                                                                 \
  do {                                                                                                   \
    _Pragma("unroll") for (int i = 0; i < 3; ++i) __builtin_amdgcn_global_load_lds(                      \
        (const unsigned*)(Kg + (pk[i] + (kt) * 64 * 192)), (unsigned*)(shm + (buf) * BUF_B + wid * 1024 + i * 8192), 16, 0, 0); \
    _Pragma("unroll") for (int i = 0; i < 2; ++i) __builtin_amdgcn_global_load_lds(                      \
        (const unsigned*)(Vg + (pv[i] + (kt) * 64)), (unsigned*)(shm + (buf) * BUF_B + KT_B + wid * 1024 + i * 8192), 16, 0, 0); \
  } while (0)
  A_STAGE(0, 0);
  asm volatile("s_waitcnt vmcnt(0)" ::: "memory");
  __syncthreads();
#pragma clang loop unroll(disable)
  for (int kt = 0; kt < ntile; ++kt) {
    const int cur = kt & 1;
    if (kt + 1 < ntile) A_STAGE(cur ^ 1, kt + 1);
    if (kt <= my_last) {
      const char* Kb = shm + cur * BUF_B;
      const char* Vb = Kb + KT_B;
      f32x4 s[4][2];
#pragma unroll
      for (int i = 0; i < 4; ++i) { s[i][0] = f32x4{0.f, 0.f, 0.f, 0.f}; s[i][1] = f32x4{0.f, 0.f, 0.f, 0.f}; }
      const char* Kf = Kb + lds_byte<6>(fr, fq * 8);
      const char* Vf = Vb + lds_byte<2>(fr, fq * 8);
      bf16x8 kf[2][4], vf0[8], vf1[8];
#pragma unroll
      for (int sub = 0; sub < 4; ++sub) kf[0][sub] = *(const bf16x8*)(Kf + sub * 6144);
#pragma unroll
      for (int ks = 0; ks < 6; ++ks) {
        if (ks < 5) {
#pragma unroll
          for (int sub = 0; sub < 4; ++sub) kf[(ks + 1) & 1][sub] = *(const bf16x8*)(Kf + sub * 6144 + (ks + 1) * 1024);
        } else {
#pragma unroll
          for (int dvs = 0; dvs < 8; ++dvs) vf0[dvs] = *(const bf16x8*)(Vf + dvs * 2048);
        }
#pragma unroll
        for (int sub = 0; sub < 4; ++sub) {
          s[sub][0] = MFMA16(kf[ks & 1][sub], qf[0][ks], s[sub][0]);
          s[sub][1] = MFMA16(kf[ks & 1][sub], qf[1][ks], s[sub][1]);
        }
      }
      __builtin_amdgcn_sched_group_barrier(0x100, 4, 0);
#pragma unroll
      for (int i = 0; i < 20; ++i) { __builtin_amdgcn_sched_group_barrier(0x100, 1, 0); __builtin_amdgcn_sched_group_barrier(0x008, 2, 0); }
#pragma unroll
      for (int i = 0; i < 4; ++i) { __builtin_amdgcn_sched_group_barrier(0x100, 2, 0); __builtin_amdgcn_sched_group_barrier(0x008, 2, 0); }
      __builtin_amdgcn_sched_barrier(0);
      bf16x8 pf[2][2];
#pragma unroll
      for (int qs = 0; qs < 2; ++qs) {
#pragma unroll
        for (int kk = 0; kk < 2; ++kk) {
          float pv[8];
#pragma unroll
          for (int j = 0; j < 4; ++j) {
            pv[j] = __builtin_amdgcn_exp2f(s[2 * kk][qs][j] - B2);
            pv[4 + j] = __builtin_amdgcn_exp2f(s[2 * kk + 1][qs][j] - B2);
          }
          lsum[qs] += ((pv[0] + pv[1]) + (pv[2] + pv[3])) + ((pv[4] + pv[5]) + (pv[6] + pv[7]));
          i32x4 pk;
#pragma unroll
          for (int e = 0; e < 4; ++e) pk[e] = (int)pack2(pv[2 * e], pv[2 * e + 1]);
          pf[kk][qs] = __builtin_bit_cast(bf16x8, pk);
        }
      }
      __builtin_amdgcn_sched_barrier(0);
#pragma unroll
      for (int dvs = 0; dvs < 8; ++dvs) vf1[dvs] = *(const bf16x8*)(Vf + dvs * 2048 + 1024);
#pragma unroll
      for (int dvs = 0; dvs < 8; ++dvs) {
        o[dvs][0] = MFMA16(vf0[dvs], pf[0][0], o[dvs][0]);
        o[dvs][1] = MFMA16(vf0[dvs], pf[0][1], o[dvs][1]);
      }
#pragma unroll
      for (int dvs = 0; dvs < 8; ++dvs) {
        o[dvs][0] = MFMA16(vf1[dvs], pf[1][0], o[dvs][0]);
        o[dvs][1] = MFMA16(vf1[dvs], pf[1][1], o[dvs][1]);
      }
#pragma unroll
      for (int i = 0; i < 8; ++i) { __builtin_amdgcn_sched_group_barrier(0x100, 1, 0); __builtin_amdgcn_sched_group_barrier(0x008, 2, 0); }
      __builtin_amdgcn_sched_group_barrier(0x008, 16, 0);
      __builtin_amdgcn_sched_barrier(0);
    }
    asm volatile("s_waitcnt vmcnt(0)" ::: "memory");
    __syncthreads();
  }
#undef A_STAGE
  u16* actC = (u16*)(P.ws + OFF_ACTC);
#pragma unroll
  for (int qs = 0; qs < 2; ++qs) {
    float lt = lsum[qs];
    lt += __shfl_xor(lt, 16);
    lt += __shfl_xor(lt, 32);
    const float inv = 1.f / lt;
    u16* dp = actC + (size_t)(b * SEQ + q0 + qs * 16 + fr) * 512 + h * 128 + fq * 4;
#pragma unroll
    for (int dvs = 0; dvs < 8; ++dvs) {
      u32x2 gz = *(const u32x2*)(dp + dvs * 16);
      u32x2 ov = {pack2(o[dvs][qs][0] * inv * bflo(gz[0]), o[dvs][qs][1] * inv * bfhi(gz[0])),
                  pack2(o[dvs][qs][2] * inv * bflo(gz[1]), o[dvs][qs][3] * inv * bfhi(gz[1]))};
      if (!dry) *(u32x2*)(dp + dvs * 16) = ov;
    }
  }
}

DI void phase_attn_c(const Params& P, int l, char* shm, int dry) {
  const int lane = tid_() & 63;
  float gq = 0.f, gk = 0.f;
#pragma unroll
  for (int i = 0; i < 3; ++i) {
    gq = fmaxf(gq, fabsf(P.q_norm_g[l * 192 + lane + i * 64]));
    gk = fmaxf(gk, fabsf(P.k_norm_g[l * 192 + lane + i * 64]));
  }
#pragma unroll
  for (int o = 32; o > 0; o >>= 1) { gq = fmaxf(gq, __shfl_xor(gq, o)); gk = fmaxf(gk, __shfl_xor(gk, o)); }
  const float B2 = 13.856406460551018f * 1.4426950408889634f * gq * gk;
  for (int it = blockIdx.x; it < 256; it += gridDim.x) {
    const int bh = it >> 4, pr = it & 15, b = bh >> 2, h = bh & 3;
#pragma clang loop unroll(disable)
    for (int hf = 0; hf < 2; ++hf) attn_c_item(P, l, b, h, hf ? pr : 31 - pr, shm, B2, dry);
  }
}

DI void phase_sgu(const Params& P, int l, char* shm, int dry = 0) {
  const int tid = tid_(), wid = tid >> 6, lane = tid & 63, fr = lane & 15, fq = lane >> 4;
  u16* vT = (u16*)shm;
  float* st = (float*)(shm + 128 * 136 * 2);
  const u16* projA = (const u16*)(P.ws + OFF_PROJA);
  u16* actA = (u16*)(P.ws + OFF_ACTA);
  const u16* Wsgu = (const u16*)(P.ws + OFF_W) + W_SGU;
  const float* lng = P.ln_v_g + l * 512;
  const float* lnb = P.ln_v_b + l * 512;
  const float* sb = P.sgu_b + l * 512;
  for (int nb = blockIdx.x; nb < 256; nb += gridDim.x) {
    const int T0 = nb * 128;
    {
      const int tok = tid >> 2, qu = tid & 3;
      const u16* p = projA + (size_t)(T0 + tok) * 1024 + 512 + qu * 128;
      float s1 = 0.f, s2 = 0.f;
#pragma unroll
      for (int i = 0; i < 16; ++i) {
        i32x4 v = *(const i32x4*)(p + i * 8);
#pragma unroll
        for (int e = 0; e < 4; ++e) {
          float a = bflo((unsigned)v[e]), c = bfhi((unsigned)v[e]);
          s1 += a + c;
          s2 += a * a + c * c;
        }
      }
      s1 += __shfl_xor(s1, 1); s2 += __shfl_xor(s2, 1);
      s1 += __shfl_xor(s1, 2); s2 += __shfl_xor(s2, 2);
      const float mean = s1 * (1.f / 512.f);
      const float var = fmaxf(s2 * (1.f / 512.f) - mean * mean, 0.f);
      if (qu == 0) { st[tok] = mean; st[128 + tok] = rsqrtf(var + EPS); }
    }
    __syncthreads();
    for (int g = 0; g < 4; ++g) {
      {
        const int s = tid >> 2, cq = tid & 3;
        const float mean = st[s], rstd = st[128 + s];
        const u16* p = projA + (size_t)(T0 + s) * 1024 + 512 + g * 128 + cq * 32;
#pragma unroll
        for (int i = 0; i < 4; ++i) {
          i32x4 v = *(const i32x4*)(p + i * 8);
#pragma unroll
          for (int e = 0; e < 4; ++e) {
            const int c = cq * 32 + i * 8 + 2 * e;
            float a = (bflo((unsigned)v[e]) - mean) * rstd * lng[g * 128 + c] + lnb[g * 128 + c];
            float d = (bfhi((unsigned)v[e]) - mean) * rstd * lng[g * 128 + c + 1] + lnb[g * 128 + c + 1];
            vT[c * 136 + s] = f2bf(a);
            vT[(c + 1) * 136 + s] = f2bf(d);
          }
        }
      }
      __syncthreads();
      f32x4 acc[8];
#pragma unroll
      for (int i = 0; i < 8; ++i) acc[i] = f32x4{0.f, 0.f, 0.f, 0.f};
      const u16* wp = Wsgu + (size_t)(g * 128 + wid * 16 + fr) * 128 + fq * 8;
#pragma unroll
      for (int ks = 0; ks < 4; ++ks) {
        bf16x8 af = *(const bf16x8*)(wp + ks * 32);
#pragma unroll
        for (int ns = 0; ns < 8; ++ns) {
          bf16x8 bfr = *(const bf16x8*)(vT + (ns * 16 + fr) * 136 + ks * 32 + fq * 8);
          acc[ns] = MFMA16(bfr, af, acc[ns]);
        }
      }
      {
        const int tl = wid * 16 + fr;
        const float bias = sb[g * 128 + tl];
        float* mx = (float*)(shm + 36864);
#pragma unroll
        for (int ns = 0; ns < 8; ++ns) {
          f32x4 v = acc[ns];
          v[0] += bias; v[1] += bias; v[2] += bias; v[3] += bias;
          *(f32x4*)(mx + tl * 132 + ns * 16 + fq * 4) = v;
        }
      }
      __syncthreads();
      {
        const float* mx = (const float*)(shm + 36864);
#pragma unroll
        for (int i = 0; i < 4; ++i) {
          const int chunk = tid + i * 512, tl = chunk >> 4, c8 = (chunk & 15) * 8, tt = T0 + tl;
          const f32x4 m0 = *(const f32x4*)(mx + tl * 132 + c8), m1 = *(const f32x4*)(mx + tl * 132 + c8 + 4);
          const i32x4 u = *(const i32x4*)(projA + (size_t)tt * 1024 + g * 128 + c8);
          u16* d = actA + (size_t)tt * 512 + g * 128 + c8;
          const i32x4 zg = *(const i32x4*)d;
          i32x4 o;
          o[0] = (int)pack2(bflo((unsigned)u[0]) * m0[0] * bflo((unsigned)zg[0]), bfhi((unsigned)u[0]) * m0[1] * bfhi((unsigned)zg[0]));
          o[1] = (int)pack2(bflo((unsigned)u[1]) * m0[2] * bflo((unsigned)zg[1]), bfhi((unsigned)u[1]) * m0[3] * bfhi((unsigned)zg[1]));
          o[2] = (int)pack2(bflo((unsigned)u[2]) * m1[0] * bflo((unsigned)zg[2]), bfhi((unsigned)u[2]) * m1[1] * bfhi((unsigned)zg[2]));
          o[3] = (int)pack2(bflo((unsigned)u[3]) * m1[2] * bflo((unsigned)zg[3]), bfhi((unsigned)u[3]) * m1[3] * bfhi((unsigned)zg[3]));
          if (!dry) *(i32x4*)d = o;
        }
      }
      __syncthreads();
    }
  }
}

DI void phase_pooled(const Params& P) {
  const u16* projB = (const u16*)(P.ws + OFF_PROJB);
  u16* pooled = (u16*)(P.ws + OFF_POOLED);
  const int gtid = blockIdx.x * 512 + tid_(), gn = gridDim.x * 512;
  for (int it = gtid; it < (T_TOK / 16) * 64; it += gn) {
    const int seg = it >> 6, c8 = it & 63, g = c8 >> 4, win = 2 << g, t0 = seg * 16, s0 = t0 & 8191;
    const u16* base = projB + (size_t)t0 * 512 + c8 * 8;
    float run[8];
#pragma unroll
    for (int e = 0; e < 8; ++e) run[e] = 0.f;
    for (int j = 1; j < win; ++j) {
      if (s0 - j >= 0) {
        const i32x4 v = *(const i32x4*)(base - (size_t)j * 512);
#pragma unroll
        for (int e = 0; e < 4; ++e) { run[2 * e] += bflo((unsigned)v[e]); run[2 * e + 1] += bfhi((unsigned)v[e]); }
      }
    }
#pragma unroll 4
    for (int i = 0; i < 16; ++i) {
      const i32x4 v = *(const i32x4*)(base + (size_t)i * 512);
      float x0[8];
#pragma unroll
      for (int e = 0; e < 4; ++e) {
        x0[2 * e] = bflo((unsigned)v[e]); x0[2 * e + 1] = bfhi((unsigned)v[e]);
        run[2 * e] += x0[2 * e]; run[2 * e + 1] += x0[2 * e + 1];
      }
      const int s = s0 + i;
      const float inv = 1.f / (float)min(s + 1, win);
      i32x4 o;
#pragma unroll
      for (int e = 0; e < 4; ++e) o[e] = (int)pack2(run[2 * e] * inv - x0[2 * e], run[2 * e + 1] * inv - x0[2 * e + 1]);
      *(i32x4*)(pooled + (size_t)(t0 + i) * 512 + c8 * 8) = o;
      if (s - win + 1 >= 0) {
        const i32x4 w = *(const i32x4*)(base + (size_t)(i - win + 1) * 512);
#pragma unroll
        for (int e = 0; e < 4; ++e) { run[2 * e] -= bflo((unsigned)w[e]); run[2 * e + 1] -= bfhi((unsigned)w[e]); }
      }
    }
  }
}

DI void phase_pool_gemm(const Params& P, char* shm) {
  const u16* pooled = (const u16*)(P.ws + OFF_POOLED);
  const u16* W = (const u16*)(P.ws + OFF_W) + W_POOL;
  u16* actB = (u16*)(P.ws + OFF_ACTB);
  const int tid = tid_(), lane = tid & 63, wid = tid >> 6, wr = wid >> 2, wc = wid & 3, fr = lane & 15, fq = lane >> 4;
  for (int tl = blockIdx.x; tl < 128 * 2; tl += gridDim.x) {
    int pm, pn;
    tile_map(tl, 128, 2, pm, pn);
    const int brow = pm * 256, bcol = pn * 256;
    f32x4 acc[8][4];
    gemm_main<8, 4>(acc, pooled + (size_t)brow * 512 + bcol, 512, W + (size_t)bcol * 512 + bcol, 512, 256, shm);
#pragma unroll
    for (int m = 0; m < 8; ++m)
#pragma unroll
      for (int n = 0; n < 4; ++n) {
        const int row = wr * 128 + m * 16 + fr, col = wc * 64 + n * 16 + fq * 4;
        u32x2 o = {pack2(acc[m][n][0], acc[m][n][1]), pack2(acc[m][n][2], acc[m][n][3])};
        *(u32x2*)(shm + row * 528 + col * 2) = o;
      }
    __syncthreads();
#pragma unroll 4
    for (int i = 0; i < 16; ++i) {
      const int chunk = tid_() + i * 512, row = chunk >> 5, c8 = (chunk & 31) * 8;
      const i32x4 v = *(const i32x4*)(shm + row * 528 + c8 * 2);
      u16* d = actB + (size_t)(brow + row) * 512 + bcol + c8;
      const i32x4 g = *(const i32x4*)d;
      i32x4 o;
#pragma unroll
      for (int e = 0; e < 4; ++e)
        o[e] = (int)pack2(bflo((unsigned)v[e]) * bflo((unsigned)g[e]), bfhi((unsigned)v[e]) * bfhi((unsigned)g[e]));
      *(i32x4*)d = o;
    }
    __syncthreads();
  }
}

DI void phase_outproj(const Params& P, char* shm) {
  constexpr int TILE_A = 32768, STAGE = 49152, NS = 96;
  const u16* hb = (const u16*)(P.ws + OFF_HB);
  const u16* W = (const u16*)(P.ws + OFF_W);
  u16* merged = (u16*)(P.ws + OFF_MERGED);
  const int tid = tid_(), lane = tid & 63, wid = tid >> 6, wr = wid >> 2, wc = wid & 3, fr = lane & 15, fq = lane >> 4;
  int sR0, sC0;
  stage_rc<2>(wid * 1024 + lane * 16, sR0, sC0);
  const int p1024 = sR0 * 1024 + sC0, p512 = sR0 * 512 + sC0;
  const int a_off = lds_byte<2>(fr, fq * 8) + wr * (8 * 2048);
  const int b_off = lds_byte<2>(fr, fq * 8) + wc * (2 * 2048);
  for (int tl = blockIdx.x; tl < 128 * 8; tl += gridDim.x) {
    int pm, pn;
    tile_map(tl, 128, 8, pm, pn);
    const int brow = pm * 256, bcol = pn * 128;
    f32x4 sum[8][2], acc[8][2];
    unsigned gq[8][2];
#pragma unroll
    for (int m = 0; m < 8; ++m)
#pragma unroll
      for (int n = 0; n < 2; ++n) {
        sum[m][n] = f32x4{0.f, 0.f, 0.f, 0.f};
      }
#define O_ISSUE(xs, rs_, buf)                                                                              \
  do {                                                                                                     \
    const bool gate_ = (rs_) < 16;                                                                         \
    const u16* Ab_ = gate_ ? hb + (size_t)brow * DM                                                        \
                           : (const u16*)(P.ws + OFF_ACTA + (size_t)(xs) * 32 * MiB) + (size_t)brow * 512; \
    const u16* Bb_ = gate_ ? W + W_IN + (size_t)(WR_GATE + (xs) * 1024 + bcol) * DM                        \
                           : W + W_A + (size_t)(xs) * 524288 + (size_t)bcol * 512;                         \
    const int ld_ = gate_ ? 1024 : 512, p0_ = gate_ ? p1024 : p512, kt_ = gate_ ? (rs_) : (rs_) - 16;      \
    _Pragma("unroll") for (int i = 0; i < 4; ++i) __builtin_amdgcn_global_load_lds(                        \
        (const unsigned*)(Ab_ + (p0_ + i * 64 * ld_ + kt_ * 64)),                                          \
        (unsigned*)(shm + (buf) * STAGE + wid * 1024 + i * 8192), 16, 0, 0);                               \
    _Pragma("unroll") for (int i = 0; i < 2; ++i) __builtin_amdgcn_global_load_lds(                        \
        (const unsigned*)(Bb_ + (p0_ + i * 64 * ld_ + kt_ * 64)),                                          \
        (unsigned*)(shm + (buf) * STAGE + TILE_A + wid * 1024 + i * 8192), 16, 0, 0);                      \
  } while (0)
    O_ISSUE(0, 0, 0);
    O_ISSUE(0, 1, 1);
    asm volatile("s_waitcnt vmcnt(6)" ::: "memory");
    asm volatile("s_waitcnt lgkmcnt(0)" ::: "memory");
    __builtin_amdgcn_s_barrier();
    int cur = 0, nxt = 2;
#define O_COMPUTE()                                                                                        \
  do {                                                                                                     \
    const char* sA = shm + cur * STAGE;                                                                    \
    const char* sB = sA + TILE_A;                                                                          \
    _Pragma("unroll") for (int ks = 0; ks < 2; ++ks) {                                                     \
      bf16x8 Bf[2], A0[4], A1[4];                                                                          \
      _Pragma("unroll") for (int n = 0; n < 2; ++n) Bf[n] = *(const bf16x8*)(sB + b_off + n * 2048 + ks * 1024); \
      _Pragma("unroll") for (int m = 0; m < 4; ++m) A0[m] = *(const bf16x8*)(sA + a_off + m * 2048 + ks * 1024); \
      _Pragma("unroll") for (int m = 0; m < 4; ++m) A1[m] = *(const bf16x8*)(sA + a_off + (4 + m) * 2048 + ks * 1024); \
      _Pragma("unroll") for (int m = 0; m < 4; ++m) _Pragma("unroll") for (int n = 0; n < 2; ++n)          \
          acc[m][n] = MFMA16(Bf[n], A0[m], acc[m][n]);                                                     \
      _Pragma("unroll") for (int m = 0; m < 4; ++m) _Pragma("unroll") for (int n = 0; n < 2; ++n)          \
          acc[4 + m][n] = MFMA16(Bf[n], A1[m], acc[4 + m][n]);                                             \
                             \
      __builtin_amdgcn_sched_group_barrier(0x100, 6, 0);                                                   \
      _Pragma("unroll") for (int i = 0; i < 4; ++i) {                                                      \
        __builtin_amdgcn_sched_group_barrier(0x100, 1, 0);                                                 \
        __builtin_amdgcn_sched_group_barrier(0x008, 2, 0);                                                 \
      }                                                                                                    \
      __builtin_amdgcn_sched_group_barrier(0x008, 8, 0);                                                   \
      __builtin_amdgcn_sched_barrier(0);                                                                   \
    }                                                                                                      \
  } while (0)
#define O_ROTATE()                                                                                         \
  do {                                                                                                     \
    asm volatile("s_waitcnt lgkmcnt(0)" ::: "memory");                                                     \
    __builtin_amdgcn_s_barrier();                                                                          \
    cur = (cur == 2) ? 0 : cur + 1;                                                                        \
    nxt = (nxt == 2) ? 0 : nxt + 1;                                                                        \
  } while (0)
#pragma clang loop unroll(disable)
    for (int x = 0; x < 4; ++x) {
#pragma unroll
      for (int m = 0; m < 8; ++m) { acc[m][0] = f32x4{0.f, 0.f, 0.f, 0.f}; acc[m][1] = f32x4{0.f, 0.f, 0.f, 0.f}; }
#pragma clang loop unroll(disable)
      for (int r = 0; r < 16; ++r) {
        O_ISSUE(x, r + 2, nxt);
        O_COMPUTE();
        asm volatile("s_waitcnt vmcnt(6)" ::: "memory");
        O_ROTATE();
      }
#pragma unroll
      for (int m = 0; m < 8; ++m)
#pragma unroll
        for (int n = 0; n < 2; ++n) {
          unsigned q = 0u;
          q = __builtin_amdgcn_cvt_pk_u8_f32(sigmoidf_(acc[m][n][0]) * 255.f, 0, q);
          q = __builtin_amdgcn_cvt_pk_u8_f32(sigmoidf_(acc[m][n][1]) * 255.f, 1, q);
          q = __builtin_amdgcn_cvt_pk_u8_f32(sigmoidf_(acc[m][n][2]) * 255.f, 2, q);
          q = __builtin_amdgcn_cvt_pk_u8_f32(sigmoidf_(acc[m][n][3]) * 255.f, 3, q);
          gq[m][n] = q;
          acc[m][n] = f32x4{0.f, 0.f, 0.f, 0.f};
        }
#pragma clang loop unroll(disable)
      for (int q = 0; q < 8; ++q) {
        const bool more = (q < 6) || (x < 3);
        if (q < 6) O_ISSUE(x, 18 + q, nxt);
        else if (x < 3) O_ISSUE(x + 1, q - 6, nxt);
        O_COMPUTE();
        if (more) asm volatile("s_waitcnt vmcnt(6)" ::: "memory");
        else asm volatile("s_waitcnt vmcnt(0)" ::: "memory");
        O_ROTATE();
      }
#pragma unroll
      for (int m = 0; m < 8; ++m)
#pragma unroll
        for (int n = 0; n < 2; ++n) {
          const unsigned q = gq[m][n];
          sum[m][n][0] += ((float)(q & 0xffu) * (1.f / 255.f)) * acc[m][n][0];
          sum[m][n][1] += ((float)((q >> 8) & 0xffu) * (1.f / 255.f)) * acc[m][n][1];
          sum[m][n][2] += ((float)((q >> 16) & 0xffu) * (1.f / 255.f)) * acc[m][n][2];
          sum[m][n][3] += ((float)(q >> 24) * (1.f / 255.f)) * acc[m][n][3];
        }
    }
#undef O_COMPUTE
#undef O_ROTATE
#undef O_ISSUE
#pragma unroll
    for (int m = 0; m < 8; ++m)
#pragma unroll
      for (int n = 0; n < 2; ++n) {
        const int row = wr * 128 + m * 16 + fr, col = wc * 32 + n * 16 + fq * 4;
        u32x2 o = {pack2(sum[m][n][0], sum[m][n][1]), pack2(sum[m][n][2], sum[m][n][3])};
        *(u32x2*)(shm + row * 272 + col * 2) = o;
      }
    __syncthreads();
#pragma unroll
    for (int i = 0; i < 8; ++i) {
      const int chunk = tid_() + i * 512, row = chunk >> 4, c8 = (chunk & 15) * 8;
      const i32x4 v = *(const i32x4*)(shm + row * 272 + c8 * 2);
      *(i32x4*)(merged + (size_t)(brow + row) * DM + bcol + c8) = v;
    }
    __syncthreads();
  }
}

DI void phase_wo(const Params& P, const float* xin, char* shm) {
  const u16* merged = (const u16*)(P.ws + OFF_MERGED);
  const u16* W = (const u16*)(P.ws + OFF_W) + W_O;
  const int tid = tid_(), lane = tid & 63, wid = tid >> 6, wr = wid >> 2, wc = wid & 3, fr = lane & 15, fq = lane >> 4;
  for (int tl = blockIdx.x; tl < 128 * 4; tl += gridDim.x) {
    int pm, pn;
    tile_map(tl, 128, 4, pm, pn);
    const int brow = pm * 256, bcol = pn * 256;
    f32x4 acc[8][4];
    gemm_main<8, 4>(acc, merged + (size_t)brow * DM, DM, W + (size_t)bcol * DM, DM, DM, shm);
#pragma unroll
    for (int ps = 0; ps < 2; ++ps) {
      if (wr == ps) {
#pragma unroll
        for (int m = 0; m < 8; ++m)
#pragma unroll
          for (int n = 0; n < 4; ++n) {
            const int row = m * 16 + fr, col = wc * 64 + n * 16 + fq * 4;
            *(f32x4*)(shm + row * 1040 + col * 4) = acc[m][n];
          }
      }
      __syncthreads();
#pragma unroll 4
      for (int i = 0; i < 16; ++i) {
        const int chunk = tid_() + i * 512, row = chunk >> 6, c4 = (chunk & 63) * 4;
        const f32x4 v = *(const f32x4*)(shm + row * 1040 + c4 * 4);
        const size_t off = (size_t)(brow + ps * 128 + row) * DM + bcol + c4;
        const f32x4 xv = *(const f32x4*)(xin + off);
        *(f32x4*)(P.out + off) = xv + v;
      }
      __syncthreads();
    }
  }
}

DI void phase_ple(const Params& P, char* shm) {
  const u16* hb = (const u16*)(P.ws + OFF_HB);
  const u16* pb = (const u16*)(P.ws + OFF_PB);
  const u16* W = (const u16*)(P.ws + OFF_W);
  const int tid = tid_(), lane = tid & 63, wid = tid >> 6, wr = wid >> 2, wc = wid & 3, fr = lane & 15, fq = lane >> 4;
  for (int tl = blockIdx.x; tl < 128 * 8; tl += gridDim.x) {
    int pm, pn;
    tile_map(tl, 128, 8, pm, pn);
    const int brow = pm * 256, bcol = pn * 128;
    f32x4 e[8][2], acc[8][2];
    gemm_main<8, 2>(e, pb + (size_t)brow * 256, 256, W + W_PLE + (size_t)bcol * 256, 256, 256, shm);
    gemm_main<8, 2>(acc, hb + (size_t)brow * DM, DM, W + W_G + (size_t)bcol * DM, DM, DM, shm);
#pragma unroll
    for (int m = 0; m < 8; ++m)
#pragma unroll
      for (int n = 0; n < 2; ++n) {
        const int row = wr * 128 + m * 16 + fr, col = wc * 32 + n * 16 + fq * 4;
        f32x4 v;
#pragma unroll
        for (int j = 0; j < 4; ++j) v[j] = sigmoidf_(acc[m][n][j]) * e[m][n][j];
        *(f32x4*)(shm + row * 528 + col * 4) = v;
      }
    __syncthreads();
#pragma unroll 4
    for (int i = 0; i < 16; ++i) {
      const int chunk = tid_() + i * 512, row = chunk >> 5, c4 = (chunk & 31) * 4;
      const f32x4 v = *(const f32x4*)(shm + row * 528 + c4 * 4);
      float* d = P.out + (size_t)(brow + row) * DM + bcol + c4;
      *(f32x4*)d = *(const f32x4*)d + v;
    }
    __syncthreads();
  }
}

DI void gbar(char* ws, int idx) {
  unsigned* cnt = (unsigned*)(ws + OFF_BAR) + idx * 64;
  asm volatile("s_waitcnt vmcnt(0)" ::: "memory");
  __syncthreads();
  if (threadIdx.x == 0) {
    __builtin_amdgcn_fence(__ATOMIC_RELEASE, "agent");
    asm volatile("s_waitcnt vmcnt(0)" ::: "memory");
    __hip_atomic_fetch_add(cnt, 1u, __ATOMIC_RELAXED, __HIP_MEMORY_SCOPE_AGENT);
    while (__hip_atomic_load(cnt, __ATOMIC_RELAXED, __HIP_MEMORY_SCOPE_AGENT) < gridDim.x) __builtin_amdgcn_s_sleep(1);
    __builtin_amdgcn_fence(__ATOMIC_ACQUIRE, "agent");
    asm volatile("s_waitcnt vmcnt(0)" ::: "memory");
  }
  __syncthreads();
}
DI unsigned xb_ld(unsigned* p) { return __hip_atomic_load(p, __ATOMIC_RELAXED, __HIP_MEMORY_SCOPE_AGENT); }
DI unsigned xb_add(unsigned* p, unsigned v) { return __hip_atomic_fetch_add(p, v, __ATOMIC_RELAXED, __HIP_MEMORY_SCOPE_AGENT); }
DI void xbar(char* ws, unsigned gen, unsigned xcc, unsigned nloc, unsigned nx) {
  unsigned* bar = (unsigned*)(ws + OFF_BAR);
  asm volatile("s_waitcnt vmcnt(0)" ::: "memory");
  __syncthreads();
  if (threadIdx.x == 0) {
    const unsigned old = xb_add(&bar[5120 + 64 * xcc], 1u);
    if (old == gen * nloc - 1u) {
      __builtin_amdgcn_fence(__ATOMIC_RELEASE, "agent");
      asm volatile("s_waitcnt vmcnt(0)" ::: "memory");
      const unsigned t = xb_add(&bar[7168], 1u);
      if (t == gen * nx - 1u) __hip_atomic_store(&bar[7232], gen, __ATOMIC_RELAXED, __HIP_MEMORY_SCOPE_AGENT);
      else while (xb_ld(&bar[7232]) < gen) __builtin_amdgcn_s_sleep(1);
      __hip_atomic_store(&bar[6144 + 64 * xcc], gen, __ATOMIC_RELAXED, __HIP_MEMORY_SCOPE_AGENT);
    } else {
      while (xb_ld(&bar[6144 + 64 * xcc]) < gen) __builtin_amdgcn_s_sleep(1);
    }
    __builtin_amdgcn_fence(__ATOMIC_ACQUIRE, "agent");
    asm volatile("s_waitcnt vmcnt(0)" ::: "memory");
  }
  __syncthreads();
}

#ifndef PROBE
#define PROBE 0
#endif
#define PH(...)                                                     \
  {                                                                 \
    Params Q = P;                                                   \
    asm volatile("" : "+s"(Q.ws), "+s"(Q.out), "+s"(Q.x));        \
    __VA_ARGS__;                                                    \
  }
__global__ void __launch_bounds__(512) fwd_megakernel(Params P) {
  __shared__ __attribute__((aligned(1024))) char shm[148480];
  cg::grid_group grid = cg::this_grid();
  const unsigned xcc = (unsigned)__builtin_amdgcn_s_getreg((3 << 11) | 20) & 0xFu;
  if (threadIdx.x == 0) xb_add((unsigned*)(P.ws + OFF_BAR) + 4096 + 64 * xcc, 1u);
  gbar(P.ws, 63);
  unsigned nloc = 0, nx = 0, bgen = 0;
  {
    unsigned* bar = (unsigned*)(P.ws + OFF_BAR);
    nloc = xb_ld(&bar[4096 + 64 * xcc]);
#pragma unroll
    for (int j = 0; j < 16; ++j) nx += (xb_ld(&bar[4096 + 64 * j]) != 0u) ? 1u : 0u;
  }
#define GSYNC(k) xbar(P.ws, ++bgen, xcc, nloc, nx)
  if (P.ws == nullptr) grid.sync();
#pragma clang loop unroll(disable)
  for (int l = 0; l < 2; ++l) {
#if PROBE == 7
    PH(phase_prep(Q, l, shm));
    PH(phase_rope(Q));
    PH(phase_norm(l == 0 ? Q.x : Q.out, (u16*)(Q.ws + OFF_HB)));
    GSYNC(0);
#endif
#if PROBE == 10
    for (int r = 0; r < 10; ++r) GSYNC(1);
#endif
    PH(phase_prep(Q, l, shm));
    if (l == 0) PH(phase_rope(Q));
    PH(phase_norm(l == 0 ? Q.x : Q.out, (u16*)(Q.ws + OFF_HB)));
    GSYNC(2);
#if PROBE == 3
    PH(phase_inproj<0>(Q, shm));
    PH(phase_inproj<1>(Q, shm));
    GSYNC(3);
#endif
    PH(phase_inproj<0>(Q, shm));
    PH(phase_inproj<1>(Q, shm));
    GSYNC(4);
    PH(phase_attn_d(Q, shm));
    PH(phase_mla_up(Q, l, shm));
    GSYNC(5);
#if PROBE == 8
    { int dry = 1; asm volatile("" : "+s"(dry)); PH(phase_kprep(Q, l, dry)); GSYNC(6); }
#endif
#if PROBE == 11
    { int dry = 1; asm volatile("" : "+s"(dry)); PH(phase_attn_d(Q, shm, dry)); GSYNC(7); }
#endif
#if PROBE == 1
    { int dry = 1; asm volatile("" : "+s"(dry)); PH(phase_attn_c(Q, l, shm, dry)); GSYNC(9); }
#endif
    PH(phase_attn_c(Q, l, shm, 0));
#if PROBE == 3
    PH(phase_inproj<2>(Q, shm));
    PH(phase_inproj<3>(Q, shm));
    GSYNC(11);
#endif
    PH(phase_inproj<2>(Q, shm));
    PH(phase_inproj<3>(Q, shm));
    GSYNC(12);
#if PROBE == 9
    { int dry = 1; asm volatile("" : "+s"(dry)); PH(phase_sgu(Q, l, shm, dry)); GSYNC(13); }
#endif
#if PROBE == 12
    PH(phase_pooled(Q)); GSYNC(14);
#endif
    PH(phase_sgu(Q, l, shm));
    PH(phase_pooled(Q));
    GSYNC(15);
    PH(phase_pool_gemm(Q, shm));
    GSYNC(16);
#if PROBE == 2
    PH(phase_outproj(Q, shm));
    GSYNC(17);
#endif
    PH(phase_outproj(Q, shm));
    GSYNC(18);
    PH(phase_wo(Q, l == 0 ? Q.x : Q.out, shm));
    GSYNC(19);
    PH(phase_norm(Q.out, (u16*)(Q.ws + OFF_HB)));
    GSYNC(20);
    PH(phase_ple(Q, shm));
    GSYNC(21);
  }
}

extern "C" void kernel_launch(void* const* d_in, const int* in_sizes, int n_in, void* d_out, int out_size,
                              void* d_ws, size_t ws_size, hipStream_t stream) {
  static int grid_blocks = 0;
  if (!grid_blocks) {
    int dev = 0, cus = 0, per_cu = 0;
    hipGetDevice(&dev);
    hipDeviceGetAttribute(&cus, hipDeviceAttributeMultiprocessorCount, dev);
    hipOccupancyMaxActiveBlocksPerMultiprocessor(&per_cu, fwd_megakernel, 512, 0);
    if (per_cu < 1) per_cu = 1;
    grid_blocks = cus * per_cu;
    if (grid_blocks > 256) grid_blocks = 256;
    grid_blocks &= ~7;
  }
  Params P{};
  P.x = (const float*)d_in[0]; P.p = (const float*)d_in[1]; P.pos = (const int*)d_in[2];
  P.norm_g = (const float*)d_in[3]; P.w_in = (const float*)d_in[4]; P.ln_v_g = (const float*)d_in[5];
  P.ln_v_b = (const float*)d_in[6]; P.sgu_w = (const float*)d_in[7]; P.sgu_b = (const float*)d_in[8];
  P.w_a_out = (const float*)d_in[9]; P.pool_w = (const float*)d_in[10]; P.pool_scale = (const float*)d_in[11];
  P.w_b_out = (const float*)d_in[12]; P.cq_norm_g = (const float*)d_in[13]; P.w_uq = (const float*)d_in[14];
  P.ckv_norm_g = (const float*)d_in[15]; P.w_ukv = (const float*)d_in[16]; P.q_norm_g = (const float*)d_in[17];
  P.k_norm_g = (const float*)d_in[18]; P.w_c_out = (const float*)d_in[19]; P.w_d_out = (const float*)d_in[20];
  P.w_o = (const float*)d_in[21]; P.w_ple = (const float*)d_in[22]; P.ple_norm_g = (const float*)d_in[23];
  P.w_ple_gate = (const float*)d_in[24];
  P.out = (float*)d_out; P.ws = (char*)d_ws;
  hipMemsetAsync((char*)d_ws + OFF_BAR, 0, 32768, stream);
  void* args[] = {&P};
  hipError_t e = hipLaunchCooperativeKernel((void*)fwd_megakernel, dim3(grid_blocks), dim3(512), args, 0, stream);
  if (e != hipSuccess) fprintf(stderr, "cooperative launch failed: %s (grid %d)\n", hipGetErrorString(e), grid_blocks);
}
```
